# Optimizing an MI355X kernel written in HIP

```python
import math
import jax, jax.numpy as jnp
from jax import lax
import numpy as np

D_MODEL = 1024
BATCH = 4
SEQ = 4096
DEPTH = 4

BLOCK = 128
A_GROUPS = 4
A_GROUP_DIM = 128
A_WIDTH = A_GROUPS * A_GROUP_DIM
B_HEADS = 4
B_QK_DIM = 64
B_V_DIM = 2 * B_QK_DIM
B_QK_WIDTH = B_HEADS * 2 * B_QK_DIM
B_WIDTH = B_HEADS * B_V_DIM
C_HEADS = 8
C_HEAD_DIM = 64
C_WIDTH = C_HEADS * C_HEAD_DIM
N_BRANCHES = 3
GATE_WIDTH = N_BRANCHES * D_MODEL
IN_SPLITS = (A_WIDTH, A_WIDTH, B_QK_WIDTH, B_QK_WIDTH, B_WIDTH, C_WIDTH, C_WIDTH, C_WIDTH, GATE_WIDTH)
IN_WIDTH = 2 * A_WIDTH + 2 * B_QK_WIDTH + B_WIDTH + 3 * C_WIDTH + GATE_WIDTH
N_EXPERTS = 16
N_GROUPS = 4
EXPERTS_PER_GROUP = N_EXPERTS // N_GROUPS
TOP_K = 2
D_FF_EXPERT = 512
EPS = 1e-6

kernel_name = "hybrid_gated_gmlp_diffattn_stickbreak_groupmoe"


def rms_norm(x, g):
    xf = x.astype(jnp.float32)
    y = xf * lax.rsqrt(jnp.mean(xf * xf, axis=-1, keepdims=True) + EPS)
    return (y * g.astype(jnp.float32)).astype(x.dtype)


def alibi_slopes(n):
    start = 2.0 ** (-8.0 / n)
    return jnp.asarray([start ** (i + 1) for i in range(n)], dtype=jnp.float32)


def chunked_spatial_gating(u, v, w_s, b_s, g_v):
    bsz, seq, _ = u.shape
    u = jax.nn.gelu(u)
    v = rms_norm(jax.nn.gelu(v), g_v)
    vc = v.reshape(bsz, seq // BLOCK, BLOCK, A_GROUPS, A_GROUP_DIM)
    causal = jnp.tril(jnp.ones((BLOCK, BLOCK), dtype=bool))
    w = jnp.where(causal[None], w_s, 0).astype(v.dtype)
    mixed = jnp.einsum('gts,bcsgd->bctgd', w, vc) + b_s.T.astype(v.dtype)[None, None, :, :, None]
    return u * mixed.reshape(bsz, seq, A_WIDTH)


def diff_attention(q, k, v, lam, slopes):
    bsz, seq = q.shape[:2]
    nb = seq // BLOCK
    scale = B_QK_DIM ** -0.5
    qb = jnp.moveaxis(q.reshape(bsz, nb, BLOCK, B_HEADS, 2, B_QK_DIM), 1, 0)
    key_pos = jnp.arange(seq)

    def one_block(args):
        qblk, i = args
        q_pos = i * BLOCK + jnp.arange(BLOCK)
        dist = (q_pos[:, None] - key_pos[None, :]).astype(jnp.float32)
        s = jnp.einsum('bqhmd,bkhmd->bhmqk', qblk, k).astype(jnp.float32) * scale
        s = s - slopes[None, :, None, None, None] * dist
        s = jnp.where(dist >= 0, s, -jnp.inf)
        p = jax.nn.softmax(s, axis=-1)
        a = p[:, :, 0] - lam * p[:, :, 1]
        return jnp.einsum('bhqk,bkhe->bqhe', a.astype(v.dtype), v)

    out = lax.map(one_block, (qb, jnp.arange(nb)))
    return jnp.moveaxis(out, 0, 1).reshape(bsz, seq, B_HEADS, B_V_DIM)


def stick_breaking_attention(q, k, v):
    bsz, seq = q.shape[:2]
    nb = seq // BLOCK
    scale = C_HEAD_DIM ** -0.5
    qb = jnp.moveaxis(q.reshape(bsz, nb, BLOCK, C_HEADS, C_HEAD_DIM), 1, 0)
    key_pos = jnp.arange(seq)

    def one_block(args):
        qblk, i = args
        q_pos = i * BLOCK + jnp.arange(BLOCK)
        strict = q_pos[:, None] > key_pos[None, :]
        z = jnp.einsum('bqhd,bkhd->bhqk', qblk, k).astype(jnp.float32) * scale
        log_beta = jax.nn.log_sigmoid(z)
        log_keep = jnp.where(strict, log_beta - z, 0.0)
        after = lax.cumsum(log_keep, axis=3, reverse=True) - log_keep
        a = jnp.where(strict, jnp.exp(log_beta + after), 0.0)
        return jnp.einsum('bhqk,bkhd->bqhd', a.astype(v.dtype), v)

    out = lax.map(one_block, (qb, jnp.arange(nb)))
    return jnp.moveaxis(out, 0, 1).reshape(bsz, seq, C_WIDTH)


def hybrid_mixer(xn, w_in, w_s, b_s, g_v, diff_lambda, subln_g, w_up_a, w_up_b, w_up_c, w_out, lambda_init):
    bsz, seq, _ = xn.shape
    proj = xn @ w_in
    points, acc = [], 0
    for width in IN_SPLITS[:-1]:
        acc += width
        points.append(acc)
    ua, va, qb, kb, vb, qc, kc, vc, gl = jnp.split(proj, points, axis=-1)

    y_a = chunked_spatial_gating(ua, va, w_s, b_s, g_v)

    lamp = diff_lambda.astype(jnp.float32)
    lam = jnp.exp(jnp.sum(lamp[0] * lamp[1])) - jnp.exp(jnp.sum(lamp[2] * lamp[3])) + lambda_init
    o_b = diff_attention(qb.reshape(bsz, seq, B_HEADS, 2, B_QK_DIM),
                         kb.reshape(bsz, seq, B_HEADS, 2, B_QK_DIM),
                         vb.reshape(bsz, seq, B_HEADS, B_V_DIM),
                         lam, alibi_slopes(B_HEADS))
    y_b = (rms_norm(o_b, subln_g) * (1.0 - lambda_init)).reshape(bsz, seq, B_WIDTH)

    y_c = stick_breaking_attention(qc.reshape(bsz, seq, C_HEADS, C_HEAD_DIM),
                                   kc.reshape(bsz, seq, C_HEADS, C_HEAD_DIM),
                                   vc.reshape(bsz, seq, C_HEADS, C_HEAD_DIM))

    g = jax.nn.sigmoid(gl.reshape(bsz, seq, N_BRANCHES, D_MODEL))
    merged = g[:, :, 0] * (y_a @ w_up_a) + g[:, :, 1] * (y_b @ w_up_b) + g[:, :, 2] * (y_c @ w_up_c)
    return merged @ w_out


def grouped_moe(xn, router_w, router_bias, w1, w3, w2):
    bsz, seq, d = xn.shape
    xt = xn.reshape(-1, d)
    aff = jax.nn.sigmoid((xt @ router_w).astype(jnp.float32))
    sel = aff + router_bias.astype(jnp.float32)
    grouped = sel.reshape(-1, N_GROUPS, EXPERTS_PER_GROUP)
    group_score = lax.top_k(grouped, TOP_K)[0].sum(-1)
    best = jnp.argmax(group_score, axis=-1)
    cand = jnp.take_along_axis(grouped, best[:, None, None], axis=1)[:, 0]
    _, local = lax.top_k(cand, TOP_K)
    idx = best[:, None] * EXPERTS_PER_GROUP + local
    w = jnp.take_along_axis(aff, idx, axis=1)
    w = w / jnp.sum(w, axis=-1, keepdims=True)
    gate = jnp.sum(jax.nn.one_hot(idx, N_EXPERTS, dtype=jnp.float32) * w[..., None], axis=1)
    h = jax.nn.silu(jnp.einsum('td,edf->tef', xt, w1)) * jnp.einsum('td,edf->tef', xt, w3)
    h = h * gate[:, :, None].astype(h.dtype)
    y = jnp.einsum('tef,efd->td', h, w2)
    return y.reshape(bsz, seq, d)


def setup_inputs(seed: int = 0) -> dict:
    key = jax.random.key(seed)
    ks = jax.random.split(key, 20)
    f32 = jnp.float32
    resid = (2 * DEPTH) ** -0.5
    nrm = lambda k, shape, s: jax.random.normal(k, shape, dtype=f32) * s
    return {
        "x": nrm(ks[0], (BATCH, SEQ, D_MODEL), 1.0),
        "norm_mix_gain": 1.0 + nrm(ks[1], (DEPTH, D_MODEL), 0.02),
        "w_in": nrm(ks[2], (DEPTH, D_MODEL, IN_WIDTH), D_MODEL ** -0.5),
        "gmlp_w_s": nrm(ks[3], (DEPTH, A_GROUPS, BLOCK, BLOCK), BLOCK ** -0.5),
        "gmlp_b_s": 1.0 + nrm(ks[4], (DEPTH, A_GROUPS, BLOCK), 0.02),
        "gmlp_v_gain": 1.0 + nrm(ks[5], (DEPTH, A_WIDTH), 0.02),
        "diff_lambda": nrm(ks[6], (DEPTH, 4, B_QK_DIM), 0.1),
        "diff_subln_gain": 1.0 + nrm(ks[7], (DEPTH, B_V_DIM), 0.02),
        "w_up_a": nrm(ks[8], (DEPTH, A_WIDTH, D_MODEL), A_WIDTH ** -0.5),
        "w_up_b": nrm(ks[9], (DEPTH, B_WIDTH, D_MODEL), B_WIDTH ** -0.5),
        "w_up_c": nrm(ks[10], (DEPTH, C_WIDTH, D_MODEL), C_WIDTH ** -0.5),
        "w_out": nrm(ks[11], (DEPTH, D_MODEL, D_MODEL), D_MODEL ** -0.5 * resid),
        "norm_ffn_gain": 1.0 + nrm(ks[12], (DEPTH, D_MODEL), 0.02),
        "router_w": nrm(ks[13], (D_MODEL, N_EXPERTS), D_MODEL ** -0.5),
        "router_bias": nrm(ks[14], (N_EXPERTS,), 0.01),
        "moe_w1": nrm(ks[15], (DEPTH, N_EXPERTS, D_MODEL, D_FF_EXPERT), D_MODEL ** -0.5),
        "moe_w3": nrm(ks[16], (DEPTH, N_EXPERTS, D_MODEL, D_FF_EXPERT), D_MODEL ** -0.5),
        "moe_w2": nrm(ks[17], (DEPTH, N_EXPERTS, D_FF_EXPERT, D_MODEL), D_FF_EXPERT ** -0.5 * resid),
        "final_gain": 1.0 + nrm(ks[18], (D_MODEL,), 0.02),
    }


def reference(x, norm_mix_gain, w_in, gmlp_w_s, gmlp_b_s, gmlp_v_gain, diff_lambda, diff_subln_gain,
              w_up_a, w_up_b, w_up_c, w_out, norm_ffn_gain, router_w, router_bias,
              moe_w1, moe_w3, moe_w2, final_gain):
    for l in range(DEPTH):
        lambda_init = 0.8 - 0.6 * math.exp(-0.3 * l)
        h = x + hybrid_mixer(rms_norm(x, norm_mix_gain[l]), w_in[l], gmlp_w_s[l], gmlp_b_s[l], gmlp_v_gain[l],
                             diff_lambda[l], diff_subln_gain[l], w_up_a[l], w_up_b[l], w_up_c[l], w_out[l],
                             lambda_init)
        x = h + grouped_moe(rms_norm(h, norm_ffn_gain[l]), router_w, router_bias,
                            moe_w1[l], moe_w3[l], moe_w2[l])
    return rms_norm(x, final_gain)
```

```cpp
#include <hip/hip_runtime.h>
#include <cstdio>
#include <cstdint>
#include <cmath>

#ifndef MK_MULTI
#define MK_MULTI 0
#endif

#define LAS __attribute__((address_space(3)))
#define GAS __attribute__((address_space(1)))
typedef unsigned short bf16_t;
typedef short bf16x8 __attribute__((ext_vector_type(8)));
typedef short s16x4 __attribute__((ext_vector_type(4)));
typedef float f32x2 __attribute__((ext_vector_type(2)));
typedef float f32x4 __attribute__((ext_vector_type(4)));
typedef float f32x16 __attribute__((ext_vector_type(16)));
typedef unsigned u32x2 __attribute__((ext_vector_type(2)));
typedef unsigned u32x4 __attribute__((ext_vector_type(4)));
typedef GAS unsigned gu32;

constexpr int NBATCH = 4, SEQ = 4096, DM = 1024, T = NBATCH * SEQ, DEPTH = 4;
constexpr int INW = 7168, NE = 16, DFF = 512;
constexpr int C_UA = 0, C_VA = 512, C_QB = 1024, C_KB = 1536, C_VB = 2048, C_QC = 2560, C_KC = 3072, C_VC = 3584, C_G = 4096;
constexpr float EPS = 1e-6f;
constexpr float LOG2E = 1.4426950408889634f;
constexpr int NWAVES = 8, NTHREADS = 512;
constexpr int LISTCAP = T;

constexpr size_t MiB = 1u << 20;
constexpr size_t WS_CTL = 0, CTL_ZERO_BYTES = 1 * MiB;
constexpr size_t WS_LIST = 1 * MiB;
constexpr size_t WS_WL = 2 * MiB;
constexpr size_t WS_W = 4 * MiB;
constexpr size_t W_IN = 0, W_UP = 14 * MiB, W_OUT = 17 * MiB, W_13 = 19 * MiB, W_2 = 51 * MiB, W_END = 67 * MiB;
constexpr size_t WS_X = 72 * MiB;
constexpr size_t WS_ACT = 136 * MiB;
constexpr size_t WS_Y = 168 * MiB;
constexpr size_t WS_PROJ = 216 * MiB;
constexpr size_t WS_H = WS_PROJ;
constexpr size_t WS_YS = WS_PROJ + 40 * MiB;
constexpr size_t WS_END = 440 * MiB;
constexpr int CW_BAR = 4096;
constexpr int CW_CNT = 16384;
constexpr int CW_ERR = 8;

constexpr int RING_BYTES = 131072;
constexpr int MISC_OFF = RING_BYTES;
constexpr int LDS_BYTES = 147456;

__device__ __forceinline__ unsigned pk2(float lo, float hi) { typedef __bf16 b2 __attribute__((ext_vector_type(2))); f32x2 v = {lo, hi}; b2 b = __builtin_convertvector(v, b2); return __builtin_bit_cast(unsigned, b); }
__device__ __forceinline__ float bf_lo(unsigned w) { return __uint_as_float(w << 16); }
__device__ __forceinline__ float bf_hi(unsigned w) { return __uint_as_float(w & 0xffff0000u); }
template <int CTRL> __device__ __forceinline__ float dpp_f(float v) { return __builtin_bit_cast(float, __builtin_amdgcn_update_dpp(0, __builtin_bit_cast(int, v), CTRL, 0xf, 0xf, true)); }
__device__ __forceinline__ float xor1_f(float v) { return dpp_f<0xB1>(v); }
__device__ __forceinline__ float xor2_f(float v) { return dpp_f<0x4E>(v); }
__device__ __forceinline__ float wave_sum(float v) {
    v += dpp_f<0xB1>(v); v += dpp_f<0x4E>(v); v += dpp_f<0x141>(v)  ; v += dpp_f<0x140>(v)  ;
    v += __builtin_bit_cast(float, __builtin_amdgcn_ds_swizzle(__builtin_bit_cast(int, v), 0x401F))  ;
    auto rr = __builtin_amdgcn_permlane32_swap(__float_as_uint(v), __float_as_uint(v), false, false);
    return __uint_as_float(rr[0]) + __uint_as_float(rr[1]);
}
__device__ __forceinline__ float other_half(float v, int hh) { auto rr = __builtin_amdgcn_permlane32_swap(__float_as_uint(v), __float_as_uint(v), false, false); return __uint_as_float(hh ? rr[0] : rr[1]); }
__device__ __forceinline__ float fexp2(float x) { return __builtin_amdgcn_exp2f(x); }
__device__ __forceinline__ float flog2(float x) { return __builtin_amdgcn_logf(x); }
__device__ __forceinline__ float frcp(float x) { return __builtin_amdgcn_rcpf(x); }
__device__ __forceinline__ float gelu_tanh(float x) { const float u = x * (1.0f + 0.044715f * x * x); return x * frcp(1.0f + fexp2(-2.3022081985f * u)); }
__device__ __forceinline__ float sigmoidf_(float x) { return frcp(1.0f + fexp2(-LOG2E * x)); }
__device__ __forceinline__ int crow(int r, int hi) { return (r & 3) + 8 * (r >> 2) + 4 * hi; }
typedef short v4i16_t __attribute__((ext_vector_type(4)));
__device__ __forceinline__ s16x4 vtr(LAS const unsigned char* p) { return __builtin_bit_cast(s16x4, __builtin_amdgcn_ds_read_tr16_b64_v4i16((LAS v4i16_t*)p)); }
#define MFMA32(a, b, c) __builtin_amdgcn_mfma_f32_32x32x16_bf16((a), (b), (c), 0, 0, 0)

namespace pg8 {
constexpr int BM = 256, BK = 64, HALF = 128, HTB = HALF * BK * 2, STAGE_BYTES = 8 * HTB, NXCD = 8, WGM = 8;
__host__ __device__ __forceinline__ int lds_byte(int r, int c) { const int st = (r >> 4) * 2 + (c >> 5), rr = r & 15, cc = c & 31, ob = rr * 64 + cc * 2; return st * 1024 + (ob ^ (((ob >> 9) & 1) << 5)); }
__host__ __device__ __forceinline__ void stage_rc(int b, int& R, int& C) { const int st = b / 1024, sb = b % 1024, swz = sb ^ (((sb >> 9) & 1) << 5); R = (st >> 1) * 16 + swz / 64; C = (st & 1) * 32 + (swz % 64) / 2; }
__host__ __device__ __forceinline__ int perm32(int rho) { const int n = rho >> 4, i = rho & 15; return 8 * (i >> 2) + 4 * n + (i & 3); }

struct Unit { int pm, pn; int e, base, n; };

struct DenseOrder {
    int nM, nN, nwg, G, c; const bf16_t* Bt; int K;
    __device__ void init(int M, int N, int K_, const bf16_t* Bt_, int G_, int c_) { nM = M / BM; nN = N / BM; nwg = nM * nN; G = G_; c = c_; Bt = Bt_; K = K_; }
    __device__ __forceinline__ bool next(int i, Unit& u) const {
        const long L = (long)i * G + c; if (L >= nwg) return false;
        int wgid = (int)L; { const int q = nwg / NXCD, r = nwg % NXCD, xcd = wgid % NXCD, off = wgid / NXCD; wgid = (xcd < r ? xcd * (q + 1) : r * (q + 1) + (xcd - r) * q) + off; }
        const int nig = WGM * nN, gid = wgid / nig, fm = gid * WGM, gsz = (nM - fm) < WGM ? (nM - fm) : WGM;
        u.pm = fm + ((wgid % nig) % gsz); u.pn = (wgid % nig) / gsz; u.e = 0; u.base = 0; u.n = 0; return true;
    }
    __device__ __forceinline__ const char* b_base(const Unit& u) const { return (const char*)Bt + (size_t)u.pn * (size_t)(BM * K * 2); }
    __device__ __forceinline__ unsigned a_row(const Unit& u, int r) const { return (unsigned)(u.pm * BM + r); }
};

template <class Epi, class Sched, bool ALIGN_EPI, bool GATHER = false>
__device__ __forceinline__ void gemm_phase(LAS unsigned char* lds, const int wave_id, const bf16_t* A, const int K, const Sched& S, const Epi& E) {
    int lane_ = (int)__builtin_amdgcn_mbcnt_hi(~0u, __builtin_amdgcn_mbcnt_lo(~0u, 0u)); asm volatile("" : "+v"(lane_));
    const int wid = wave_id, lane = lane_, tid = wid * 64 + lane, wr = wid >> 2, wc = wid & 3, fr = lane & 15, fq = lane >> 4;
    const int nt = K / BK;
    int RA[2], CA[2]; unsigned voffB[2], voffA[2];
#pragma unroll
    for (int i = 0; i < 2; ++i) { int R, C; stage_rc(tid * 16 + i * 8192, R, C); const int Rb = Epi::PERM ? ((R & ~31) + perm32(R & 31)) : R;
        RA[i] = R; CA[i] = C; voffB[i] = (unsigned)(Rb * K + C) * 2u; voffA[i] = (unsigned)(R * K + C) * 2u; }
    const size_t kstep = (size_t)(BK * 2);
    const size_t hstep = (size_t)HALF * K * 2;
    const size_t tstep = 2 * hstep;
    const unsigned ldsw = (unsigned)wid * 1024u;
    const int aoff = lds_byte(wr * 64 + fr, fq * 8), boff = lds_byte(wc * 32 + fr, fq * 8);
#define PG8_SA(b, h) (((b) * 2 + (h)) * HTB)
#define PG8_SB(b, h) ((4 + (b) * 2 + (h)) * HTB)
#define PG8_STAGE(bufoff, gbase, voff) do { _Pragma("unroll") for (int _i = 0; _i < 2; ++_i) \
        __builtin_amdgcn_global_load_lds((const unsigned*)((const char*)(gbase) + (voff)[_i]), (LAS unsigned*)(lds + (bufoff) + ldsw + _i * 8192), 16, 0, 0); } while (0)
#define PG8_LDA(dst, b, h) do { _Pragma("unroll") for (int m = 0; m < 4; ++m) _Pragma("unroll") for (int k = 0; k < 2; ++k) dst[m][k] = *(const LAS bf16x8*)(lds + PG8_SA(b, h) + aoff + m * 2048 + k * 1024); } while (0)
#define PG8_LDB(dst, b, h) do { _Pragma("unroll") for (int n = 0; n < 2; ++n) _Pragma("unroll") for (int k = 0; k < 2; ++k) dst[n][k] = *(const LAS bf16x8*)(lds + PG8_SB(b, h) + boff + n * 2048 + k * 1024); } while (0)
#define PG8_MMA(ai, bj, At, Bt) do { __builtin_amdgcn_s_setprio(1); _Pragma("unroll") for (int m = 0; m < 4; ++m) _Pragma("unroll") for (int n = 0; n < 2; ++n) _Pragma("unroll") for (int k = 0; k < 2; ++k) \
        acc[ai][bj][m][n] = __builtin_amdgcn_mfma_f32_16x16x32_bf16(Bt[n][k], At[m][k], acc[ai][bj][m][n], 0, 0, 0); __builtin_amdgcn_s_setprio(0); } while (0)
#define PG8_WAIT_V(n) asm volatile("s_waitcnt vmcnt(" #n ")" ::: "memory")
#define PG8_WAIT_L(n) asm volatile("s_waitcnt lgkmcnt(" #n ")" ::: "memory")
#define PG8_BAR __builtin_amdgcn_s_barrier()
#define PG8_SCHED __builtin_amdgcn_sched_barrier(0)
#define PG8_STA(bufoff, kb, h, nx) do { if constexpr (GATHER) { _Pragma("unroll") for (int _i = 0; _i < 2; ++_i) \
        __builtin_amdgcn_global_load_lds((const unsigned*)(Ab + (kb) + ((nx) ? vN[h][_i] : vA[h][_i])), (LAS unsigned*)(lds + (bufoff) + ldsw + _i * 8192), 16, 0, 0); } \
        else { PG8_STAGE(bufoff, ((nx) ? nA : cA) + (kb) + (h) * hstep, voffA); } } while (0)
#define PG8_AOFFS(dst, u) do { _Pragma("unroll") for (int _h = 0; _h < 2; ++_h) _Pragma("unroll") for (int _i = 0; _i < 2; ++_i) \
        dst[_h][_i] = (S.a_row((u), _h * HALF + RA[_i]) * (unsigned)K + (unsigned)CA[_i]) * 2u; } while (0)
    Unit cur, nxt; int ui = 0;
    if (!S.next(0, cur)) return;
    f32x4 acc[2][2][4][2];
#pragma unroll
    for (int a = 0; a < 2; ++a)
#pragma unroll
        for (int b = 0; b < 2; ++b)
#pragma unroll
            for (int m = 0; m < 4; ++m)
#pragma unroll
                for (int n = 0; n < 2; ++n) acc[a][b][m][n] = (f32x4){0.f, 0.f, 0.f, 0.f};
    bf16x8 At[4][2], B0[2][2], B1[2][2];
    unsigned vA[2][2], vN[2][2];
    const char* const Ab = (const char*)A;
    const char* cA = Ab; const char* nA = Ab;
    if constexpr (GATHER) { PG8_AOFFS(vA, cur); } else { cA = Ab + (size_t)cur.pm * tstep; }
    const char* cB = S.b_base(cur);
    PG8_STAGE(PG8_SB(0, 0), cB, voffB); PG8_STAGE(PG8_SB(0, 1), cB + hstep, voffB); PG8_STA(PG8_SA(0, 0), 0, 0, false); PG8_STA(PG8_SA(0, 1), 0, 1, false);
    if (wr == 1) PG8_BAR;
    PG8_WAIT_V(2); PG8_BAR;
    PG8_STAGE(PG8_SB(1, 0), cB + kstep, voffB); PG8_STA(PG8_SA(1, 0), kstep, 0, false); PG8_STAGE(PG8_SB(1, 1), cB + hstep + kstep, voffB);
    PG8_WAIT_V(6); PG8_BAR;
    for (;;) {
        const bool has_next = S.next(ui + 1, nxt);
        if (!has_next) nxt = cur;
        if constexpr (GATHER) { PG8_AOFFS(vN, nxt); } else { nA = Ab + (size_t)nxt.pm * tstep; }
        const char* nB = has_next ? S.b_base(nxt) : cB;
        for (int t = 0; t < nt; t += 2) {
            const bool last = (t == nt - 2);
            const size_t k1 = (size_t)(t + 1) * kstep;
            const size_t k2 = last ? (size_t)0 : (size_t)(t + 2) * kstep; const char* b2 = last ? nB : cB + (size_t)(t + 2) * kstep;
            const size_t k3 = k2 + kstep; const char* b3 = b2 + kstep;
            PG8_LDB(B0, 0, 0); PG8_LDB(B1, 0, 1); PG8_SCHED; PG8_LDA(At, 0, 0); PG8_STA(PG8_SA(1, 1), k1, 1, false);
            PG8_WAIT_V(8); PG8_WAIT_L(0); PG8_BAR; PG8_MMA(0, 0, At, B0); PG8_MMA(0, 1, At, B1); PG8_BAR; PG8_SCHED;
            PG8_LDA(At, 0, 1); PG8_STAGE(PG8_SB(0, 0), b2, voffB); PG8_STAGE(PG8_SB(0, 1), b2 + hstep, voffB); PG8_STA(PG8_SA(0, 0), k2, 0, last);
            PG8_WAIT_V(8); PG8_WAIT_L(0); PG8_BAR; PG8_MMA(1, 0, At, B0); PG8_MMA(1, 1, At, B1); PG8_BAR; PG8_SCHED;
            PG8_LDB(B0, 1, 0); PG8_LDB(B1, 1, 1); PG8_SCHED; PG8_LDA(At, 1, 0); PG8_STA(PG8_SA(0, 1), k2, 1, last);
            PG8_WAIT_V(8); PG8_WAIT_L(0); PG8_BAR; PG8_MMA(0, 0, At, B0); PG8_MMA(0, 1, At, B1); PG8_BAR; PG8_SCHED;
            PG8_LDA(At, 1, 1); PG8_STAGE(PG8_SB(1, 0), b3, voffB); PG8_STAGE(PG8_SB(1, 1), b3 + hstep, voffB); PG8_STA(PG8_SA(1, 0), k3, 0, last);
            PG8_WAIT_V(8); PG8_WAIT_L(0); PG8_BAR; PG8_MMA(1, 0, At, B0); PG8_MMA(1, 1, At, B1); PG8_BAR; PG8_SCHED;
        }
        if constexpr (ALIGN_EPI) { if (wr == 0) PG8_BAR; }
        E(acc, cur, wr, wc, fr, fq);
        if (!has_next) break;
#pragma unroll
        for (int a = 0; a < 2; ++a)
#pragma unroll
            for (int b = 0; b < 2; ++b)
#pragma unroll
                for (int m = 0; m < 4; ++m)
#pragma unroll
                    for (int n = 0; n < 2; ++n) acc[a][b][m][n] = (f32x4){0.f, 0.f, 0.f, 0.f};
        cur = nxt; cB = nB; cA = nA; ++ui;
        if constexpr (GATHER) {
#pragma unroll
            for (int h = 0; h < 2; ++h)
#pragma unroll
                for (int i = 0; i < 2; ++i) vA[h][i] = vN[h][i]; }
        if constexpr (ALIGN_EPI) { if (wr == 1) PG8_BAR; }
    }
    PG8_WAIT_V(0);
    if constexpr (!ALIGN_EPI) { if (wr == 0) PG8_BAR; }
    PG8_BAR;
#undef PG8_SA
#undef PG8_SB
#undef PG8_STAGE
#undef PG8_LDA
#undef PG8_LDB
#undef PG8_MMA
#undef PG8_WAIT_V
#undef PG8_WAIT_L
#undef PG8_BAR
#undef PG8_SCHED
#undef PG8_AOFFS
#undef PG8_STA
}

struct EpiProj {
    static constexpr bool PERM = true;
    bf16_t* O;
    __device__ __forceinline__ void operator()(const f32x4 (&acc)[2][2][4][2], const Unit& u, int wr, int wc, int fr, int fq) const {
        const int row0 = u.pm * BM + wr * 64 + fr, col0 = u.pn * BM + wc * 32 + 8 * fq;
        const int mode = (u.pn < 4) ? 1 : (u.pn < 16 ? 0 : 2);
#pragma unroll
        for (int ai = 0; ai < 2; ++ai)
#pragma unroll
            for (int m = 0; m < 4; ++m) { bf16_t* rowp = O + (size_t)(row0 + ai * HALF + m * 16) * INW + col0;
#pragma unroll
                for (int bj = 0; bj < 2; ++bj) { f32x4 v0 = acc[ai][bj][m][0], v1 = acc[ai][bj][m][1];
                    if (mode == 1) {
#pragma unroll
                        for (int c = 0; c < 4; ++c) { v0[c] = gelu_tanh(v0[c]); v1[c] = gelu_tanh(v1[c]); }
                    } else if (mode == 2) {
#pragma unroll
                        for (int c = 0; c < 4; ++c) { v0[c] = sigmoidf_(v0[c]); v1[c] = sigmoidf_(v1[c]); }
                    }
                    u32x4 w; w.x = pk2(v0[0], v0[1]); w.y = pk2(v0[2], v0[3]); w.z = pk2(v1[0], v1[1]); w.w = pk2(v1[2], v1[3]);
                    *(u32x4*)(rowp + bj * HALF) = w; } }
    }
};
template <bool FIRST> struct EpiGate {
    static constexpr bool PERM = true;
    bf16_t* P; const bf16_t* Gt;
    __device__ __forceinline__ void operator()(const f32x4 (&acc)[2][2][4][2], const Unit& u, int wr, int wc, int fr, int fq) const {
        const int row0 = u.pm * BM + wr * 64 + fr, col0 = u.pn * BM + wc * 32 + 8 * fq;
#pragma unroll
        for (int ai = 0; ai < 2; ++ai)
#pragma unroll
            for (int m = 0; m < 4; ++m) { const int row = row0 + ai * HALF + m * 16; asm volatile("" ::: "memory");
#pragma unroll
                for (int bj = 0; bj < 2; ++bj) {
                    const u32x4 g = *(const u32x4*)(Gt + (size_t)row * INW + col0 + bj * HALF);
                    bf16_t* pp = P + (size_t)row * DM + col0 + bj * HALF;
                    const f32x4 a0 = acc[ai][bj][m][0], a1 = acc[ai][bj][m][1];
                    float o[8];
                    o[0] = bf_lo(g.x) * a0[0]; o[1] = bf_hi(g.x) * a0[1]; o[2] = bf_lo(g.y) * a0[2]; o[3] = bf_hi(g.y) * a0[3];
                    o[4] = bf_lo(g.z) * a1[0]; o[5] = bf_hi(g.z) * a1[1]; o[6] = bf_lo(g.w) * a1[2]; o[7] = bf_hi(g.w) * a1[3];
                    if (!FIRST) { const u32x4 p = *(const u32x4*)pp;
                        o[0] += bf_lo(p.x); o[1] += bf_hi(p.x); o[2] += bf_lo(p.y); o[3] += bf_hi(p.y); o[4] += bf_lo(p.z); o[5] += bf_hi(p.z); o[6] += bf_lo(p.w); o[7] += bf_hi(p.w); }
                    u32x4 w; w.x = pk2(o[0], o[1]); w.y = pk2(o[2], o[3]); w.z = pk2(o[4], o[5]); w.w = pk2(o[6], o[7]);
                    *(u32x4*)pp = w; } }
    }
};
struct EpiRes {
    static constexpr bool PERM = true;
    float* X;
    __device__ __forceinline__ void operator()(const f32x4 (&acc)[2][2][4][2], const Unit& u, int wr, int wc, int fr, int fq) const {
        const int row0 = u.pm * BM + wr * 64 + fr, col0 = u.pn * BM + wc * 32 + 8 * fq;
#pragma unroll
        for (int ai = 0; ai < 2; ++ai)
#pragma unroll
            for (int m = 0; m < 4; ++m) { float* rowp = X + (size_t)(row0 + ai * HALF + m * 16) * DM + col0; asm volatile("" ::: "memory");
#pragma unroll
                for (int bj = 0; bj < 2; ++bj) { f32x4* p = (f32x4*)(rowp + bj * HALF);
                    const f32x4 x0 = p[0], x1 = p[1]; p[0] = x0 + acc[ai][bj][m][0]; p[1] = x1 + acc[ai][bj][m][1]; } }
    }
};
struct EpiMoe1 {
    static constexpr bool PERM = true;
    bf16_t* H; const float* WL;
    __device__ __forceinline__ void operator()(const f32x4 (&acc)[2][2][4][2], const Unit& u, int wr, int wc, int fr, int fq) const {
        const int r0 = wr * 64 + fr, col0 = u.pn * HALF + wc * 32 + 8 * fq;
#pragma unroll
        for (int ai = 0; ai < 2; ++ai)
#pragma unroll
            for (int m = 0; m < 4; ++m) { const int r = r0 + ai * HALF + m * 16; const int li = u.base + r;
                const float wt = (li < u.n) ? WL[(size_t)u.e * LISTCAP + li] : 0.f;
                const f32x4 a0 = acc[ai][0][m][0], a1 = acc[ai][0][m][1], b0 = acc[ai][1][m][0], b1 = acc[ai][1][m][1];
                float o[8];
#pragma unroll
                for (int c = 0; c < 4; ++c) { o[c] = a0[c] * sigmoidf_(a0[c]) * b0[c] * wt; o[4 + c] = a1[c] * sigmoidf_(a1[c]) * b1[c] * wt; }
                u32x4 w; w.x = pk2(o[0], o[1]); w.y = pk2(o[2], o[3]); w.z = pk2(o[4], o[5]); w.w = pk2(o[6], o[7]);
                *(u32x4*)(H + (size_t)(u.pm * BM + r) * DFF + col0) = w; }
    }
};
struct EpiMoe2 {
    static constexpr bool PERM = true;
    bf16_t* YS; const unsigned* LIST;
    __device__ __forceinline__ void operator()(const f32x4 (&acc)[2][2][4][2], const Unit& u, int wr, int wc, int fr, int fq) const {
        const int r0 = wr * 64 + fr, col0 = u.pn * BM + wc * 32 + 8 * fq;
#pragma unroll
        for (int ai = 0; ai < 2; ++ai)
#pragma unroll
            for (int m = 0; m < 4; ++m) { const int r = r0 + ai * HALF + m * 16; const int li = u.base + r; asm volatile("" ::: "memory");
                if (li < u.n) { const unsigned ent = LIST[(size_t)u.e * LISTCAP + li]; const unsigned tok = ent & 0x7fffffffu, slot = ent >> 31;
                    bf16_t* rowp = YS + ((size_t)slot * T + tok) * DM + col0;
#pragma unroll
                    for (int bj = 0; bj < 2; ++bj) { const f32x4 v0 = acc[ai][bj][m][0], v1 = acc[ai][bj][m][1];
                        u32x4 w; w.x = pk2(v0[0], v0[1]); w.y = pk2(v0[2], v0[3]); w.z = pk2(v1[0], v1[1]); w.w = pk2(v1[2], v1[3]);
                        *(u32x4*)(rowp + bj * HALF) = w; } } }
    }
};
}

template <bool GATHER> struct MoeOrder {
    int G, c, npn; const LAS int* PFX; const LAS int* CNT; const bf16_t* Bt; size_t estride; int K; const unsigned* LIST;
    __device__ __forceinline__ bool next(int i, pg8::Unit& u) const {
        const int L = i * G + c; const int rt = L / npn; if (rt >= PFX[16]) return false;
        const int e = PFX[32 + rt];
        u.pm = rt; u.pn = L % npn; u.e = e; u.base = (rt - PFX[e]) * 256; u.n = CNT[e]; return true;
    }
    __device__ __forceinline__ const char* b_base(const pg8::Unit& u) const { return (const char*)Bt + (size_t)u.e * estride + (size_t)u.pn * (size_t)(256 * K * 2); }
    __device__ __forceinline__ unsigned a_row(const pg8::Unit& u, int r) const {
        if (GATHER) { const int li = u.base + r; return (li < u.n) ? (LIST[(size_t)u.e * LISTCAP + li] & 0x7fffffffu) : 0u; }
        return (unsigned)(u.pm * 256 + r);
    }
};

#define XB_TMO      128
#define XB_XCNT(j)  (256  + 64 * (j))
#define XB_XSUB(j)  (1280 + 64 * (j))
#define XB_XGEN(j)  (2304 + 64 * (j))
#define XB_TOP      3328
#define XB_TOPGEN   3392
#define XCD_BAR_WORDS 3456
#define XB_SPIN_CAP (1u << 18)
__device__ __forceinline__ unsigned xb_ld(unsigned* p)              { return __hip_atomic_load(p, __ATOMIC_RELAXED, __HIP_MEMORY_SCOPE_AGENT); }
__device__ __forceinline__ unsigned xb_add(unsigned* p, unsigned v) { return __hip_atomic_fetch_add(p, v, __ATOMIC_RELAXED, __HIP_MEMORY_SCOPE_AGENT); }
__device__ __forceinline__ unsigned xb_xcc_id() { return (unsigned)__builtin_amdgcn_s_getreg((3 << 11) | 20) & 0xFu; }
#define XB_SPIN(cond, bar) do { unsigned _sp = 0; while (cond) { __builtin_amdgcn_s_sleep(1); \
    if ((++_sp & 255u) == 0u) { if (xb_ld(&(bar)[XB_TMO])) break; if (_sp > XB_SPIN_CAP) { atomicAdd(&(bar)[XB_TMO], 1u); break; } } } } while (0)
struct XcdBarrier { unsigned* bar; unsigned x; volatile LAS unsigned* st; };
__device__ __forceinline__ XcdBarrier xcd_barrier_post(unsigned* bar, volatile LAS unsigned* st) {
    XcdBarrier b; b.bar = bar; b.x = xb_xcc_id(); b.st = st;
    if (threadIdx.x == 0) (void)xb_add(&bar[XB_XCNT(b.x)], 1u);
    return b;
}
__device__ __forceinline__ void xcd_barrier_complete(unsigned* bar, unsigned x, unsigned& nloc, unsigned& nx) {
    const unsigned G = gridDim.x * gridDim.y * gridDim.z;
    unsigned sum, cnt, mine, sp = 0u;
    for (;;) {
        sum = 0u; cnt = 0u; mine = 0u;
#pragma unroll
        for (unsigned j = 0; j < 16; ++j) { const unsigned c = xb_ld(&bar[XB_XCNT(j)]); sum += c; cnt += (c > 0u) ? 1u : 0u; mine = (j == x) ? c : mine; }
        if (sum == G) break;
        __builtin_amdgcn_s_sleep(1);
        if ((++sp & 255u) == 0u) { if (xb_ld(&bar[XB_TMO])) break; if (sp > XB_SPIN_CAP) { atomicAdd(&bar[XB_TMO], 1u); break; } }
    }
    nloc = mine > 0u ? mine : 1u; nx = cnt > 0u ? cnt : 1u;
}
__device__ __forceinline__ void xcd_barrier(const XcdBarrier& b) {
    asm volatile("s_waitcnt vmcnt(0)" ::: "memory");
    __syncthreads();
    if (threadIdx.x == 0) {
        unsigned* bar = b.bar;
        __builtin_amdgcn_s_waitcnt(0);
        unsigned nloc = b.st[0], nx = b.st[1];
        if (nloc == 0u) { xcd_barrier_complete(bar, b.x, nloc, nx); b.st[0] = nloc; b.st[1] = nx; }
        const unsigned old = xb_add(&bar[XB_XSUB(b.x)], 1u);
        const unsigned gen = old / nloc;
        if (old + 1u == (gen + 1u) * nloc) {
            __builtin_amdgcn_fence(__ATOMIC_RELEASE, "agent");
            asm volatile("s_waitcnt vmcnt(0)" ::: "memory");
            const unsigned og = xb_add(&bar[XB_TOP], 1u);
            const unsigned tg = og / nx;
            if (og + 1u == (tg + 1u) * nx) xb_add(&bar[XB_TOPGEN], 1u);
            else XB_SPIN(xb_ld(&bar[XB_TOPGEN]) == tg, bar);
            __builtin_amdgcn_fence(__ATOMIC_ACQUIRE, "agent");
            xb_add(&bar[XB_XGEN(b.x)], 1u);
            asm volatile("s_waitcnt vmcnt(0)" ::: "memory");
        } else {
            XB_SPIN(xb_ld(&bar[XB_XGEN(b.x)]) == gen, bar);
            __builtin_amdgcn_fence(__ATOMIC_ACQUIRE, "agent");
            asm volatile("s_waitcnt vmcnt(0)" ::: "memory");
        }
    }
    __syncthreads();
}

struct Args { const float* in[19]; float* out; unsigned char* ws; int ph_lo, ph_hi; float lam_init[4]; };
typedef const __attribute__((address_space(4))) Args* ArgsP;
typedef const GAS float* gfp;
#define GIN(i) ((gfp)a->in[i])
enum { I_X = 0, I_GMIX, I_WIN, I_WS, I_BS, I_GV, I_LAM, I_SUBLN, I_UPA, I_UPB, I_UPC, I_WOUT, I_GFFN, I_RW, I_RB, I_W1, I_W3, I_W2, I_FG };

struct Frame {
    LAS unsigned char* lds;
    gu32* ctl;
    int tid, lane, wave, vcu, G;
    unsigned char* ws;
};

__device__ __forceinline__ Frame phase_frame(const Frame& F0) {
    Frame F = F0; int ln = (int)__builtin_amdgcn_mbcnt_hi(~0u, __builtin_amdgcn_mbcnt_lo(~0u, 0u)); asm volatile("" : "+v"(ln)); F.lane = ln; F.tid = F0.wave * 64 + ln;
    size_t z = 0; asm volatile("" : "+s"(z)); unsigned char* w = F0.ws + z; F.ws = w; F.ctl = (gu32*)(w + WS_CTL);
    int v = F0.vcu, g = F0.G; asm volatile("" : "+s"(v), "+s"(g)); F.vcu = v; F.G = g;
    return F;
}
__device__ __forceinline__ void transpose_item(gfp W, int K, int N, bf16_t* WT, int rowT0, int k0, int n0, LAS float* scr, int lane) {
#pragma unroll 8
    for (int i = 0; i < 32; ++i) { const int kk = 2 * i + (lane >> 5); scr[kk * 33 + (lane & 31)] = W[(size_t)(k0 + kk) * N + n0 + (lane & 31)]; }
    asm volatile("s_waitcnt lgkmcnt(0)" ::: "memory");
    const int c = lane & 7;
#pragma unroll
    for (int j = 0; j < 4; ++j) { const int n = (lane >> 3) + 8 * j; const LAS float* s = scr + (8 * c) * 33 + n;
        u32x4 o; o.x = pk2(s[0 * 33], s[1 * 33]); o.y = pk2(s[2 * 33], s[3 * 33]); o.z = pk2(s[4 * 33], s[5 * 33]); o.w = pk2(s[6 * 33], s[7 * 33]);
        *(GAS u32x4*)(WT + (size_t)(rowT0 + n) * K + k0 + 8 * c) = o; }
    asm volatile("s_waitcnt lgkmcnt(0)" ::: "memory");
}
__device__ __forceinline__ void tr_matrix_item(gfp W, int K, int N, bf16_t* WT, int it, LAS float* scr, int lane) {
    const int nblk = N / 32, kb = it / nblk, nb = it % nblk;
    transpose_item(W, K, N, WT, 32 * nb, 64 * kb, 32 * nb, scr, lane);
}
__device__ __forceinline__ void convert_weights(const Frame& F_, ArgsP a, int l) {
    const Frame F = phase_frame(F_);
    LAS float* scr = (LAS float*)(F.lds + F.wave * 16384);
    const int gw = F.vcu * NWAVES + F.wave, NGW = F.G * NWAVES;
    bf16_t* Wb = (bf16_t*)(F.ws + WS_W);
    constexpr int I_IN = (DM / 64) * (INW / 32);
    constexpr int I_UP1 = (512 / 64) * (DM / 32);
    constexpr int I_OUT = (DM / 64) * (DM / 32);
    constexpr int I_E1 = (DM / 64) * (DFF / 32);
    constexpr int I_E2 = (DFF / 64) * (DM / 32);
    constexpr int I_EX = 2 * I_E1 + I_E2;
    constexpr int NITEMS = I_IN + 3 * I_UP1 + I_OUT + NE * I_EX;
    for (int it = gw; it < NITEMS; it += NGW) {
        int r = it;
        if (r < I_IN) { tr_matrix_item(GIN(I_WIN) + (size_t)l * DM * INW, DM, INW, Wb + W_IN / 2, r, scr, F.lane); continue; } r -= I_IN;
        if (r < 3 * I_UP1) { const int s = r / I_UP1; tr_matrix_item(GIN(I_UPA + s) + (size_t)l * 512 * DM, 512, DM, Wb + W_UP / 2 + (size_t)s * DM * 512, r % I_UP1, scr, F.lane); continue; } r -= 3 * I_UP1;
        if (r < I_OUT) { tr_matrix_item(GIN(I_WOUT) + (size_t)l * DM * DM, DM, DM, Wb + W_OUT / 2, r, scr, F.lane); continue; } r -= I_OUT;
        const int e = r / I_EX; r %= I_EX;
        if (r < 2 * I_E1) { const int which = r / I_E1; r %= I_E1;
            gfp W = GIN(which ? I_W3 : I_W1) + ((size_t)l * NE + e) * DM * DFF;
            const int nblk = DFF / 32, kb = r / nblk, nb = r % nblk, n0 = 32 * nb;
            transpose_item(W, DM, DFF, Wb + W_13 / 2 + (size_t)e * DM * DM, 256 * (n0 / 128) + 128 * which + (n0 % 128), 64 * kb, n0, scr, F.lane);
        } else { r -= 2 * I_E1;
            tr_matrix_item(GIN(I_W2) + ((size_t)l * NE + e) * DFF * DM, DFF, DM, Wb + W_2 / 2 + (size_t)e * DM * DFF, r, scr, F.lane); }
    }
}

template <int MODE  >
__device__ __forceinline__ void norm_rows(const Frame& F_, ArgsP a, int l) {
    const Frame F = phase_frame(F_);
    gfp gain = (MODE == 2) ? GIN(I_FG) : GIN(I_GMIX) + (size_t)l * DM;
    float* X = (float*)(F.ws + WS_X); bf16_t* XN = (bf16_t*)(F.ws + WS_ACT); const bf16_t* YS = (const bf16_t*)(F.ws + WS_YS);
    f32x4 g[4];
#pragma unroll
    for (int j = 0; j < 4; ++j) g[j] = *(const GAS f32x4*)(gain + 256 * j + 4 * F.lane);
    const int gw = F.vcu * NWAVES + F.wave, NGW = F.G * NWAVES;
    for (int m = gw; m < T; m += NGW) {
        gfp src = (MODE == 0) ? GIN(I_X) + (size_t)m * DM : (gfp)X + (size_t)m * DM;
        f32x4 v[4]; float ss = 0.f;
#pragma unroll
        for (int j = 0; j < 4; ++j) { v[j] = *(const GAS f32x4*)(src + 256 * j + 4 * F.lane);
            if (MODE != 0) {
                const u32x2 y0 = *(const u32x2*)(YS + (size_t)m * DM + 256 * j + 4 * F.lane), y1 = *(const u32x2*)(YS + ((size_t)T + m) * DM + 256 * j + 4 * F.lane);
                v[j][0] += bf_lo(y0.x) + bf_lo(y1.x); v[j][1] += bf_hi(y0.x) + bf_hi(y1.x); v[j][2] += bf_lo(y0.y) + bf_lo(y1.y); v[j][3] += bf_hi(y0.y) + bf_hi(y1.y); }
            ss += (v[j][0] * v[j][0] + v[j][1] * v[j][1]) + (v[j][2] * v[j][2] + v[j][3] * v[j][3]); }
        const float rstd = 1.0f / sqrtf(wave_sum(ss) * (1.0f / DM) + EPS);
#pragma unroll
        for (int j = 0; j < 4; ++j) {
            const f32x4 o = v[j] * rstd * g[j];
            if (MODE == 2) *(GAS f32x4*)((GAS float*)a->out + (size_t)m * DM + 256 * j + 4 * F.lane) = o;
            else { *(f32x4*)(X + (size_t)m * DM + 256 * j + 4 * F.lane) = v[j];
                   u32x2 w; w.x = pk2(o[0], o[1]); w.y = pk2(o[2], o[3]); *(u32x2*)(XN + (size_t)m * DM + 256 * j + 4 * F.lane) = w; } }
    }
}

__device__ __forceinline__ void t2_phase(const Frame& F_, ArgsP a, int l) {
    const Frame F = phase_frame(F_);
    LAS float* RW = (LAS float*)(F.lds);
    LAS float* lsc = (LAS float*)(F.lds + 65536 + F.wave * 256);
    LAS int* lcnt = (LAS int*)(F.lds + 69632);
    LAS int* gbase = lcnt + 16;
    LAS int* tE = lcnt + 32;
    LAS int* tP = tE + 128;
    LAS float* tW = (LAS float*)(tP + 128);
    gfp rw = GIN(I_RW); gfp rb = GIN(I_RB); gfp gain = GIN(I_GFFN) + (size_t)l * DM;
    const float* X = (const float*)(F.ws + WS_X); bf16_t* XN = (bf16_t*)(F.ws + WS_ACT);
    unsigned* LIST = (unsigned*)(F.ws + WS_LIST); float* WL = (float*)(F.ws + WS_WL);
    for (int i = F.tid; i < DM * NE / 4; i += NTHREADS) ((LAS f32x4*)RW)[i] = ((const GAS f32x4*)rw)[i];
    if (F.tid < 32) lcnt[F.tid] = 0;
    __syncthreads();
    f32x4 g[4];
#pragma unroll
    for (int j = 0; j < 4; ++j) g[j] = *(const GAS f32x4*)(gain + 256 * j + 4 * F.lane);
    const int rows_per_wg = T / F.G;
    const int row0 = F.vcu * rows_per_wg;
    constexpr int RB = 2;
#pragma unroll 1
    for (int bt = 0; bt < rows_per_wg / (NWAVES * RB); ++bt) {
        const int lr0 = (bt * NWAVES + F.wave) * RB;
        float hn[RB][16];
#pragma unroll
        for (int r = 0; r < RB; ++r) { const int m = row0 + lr0 + r; f32x4 v[4]; float ss = 0.f;
#pragma unroll
            for (int j = 0; j < 4; ++j) { v[j] = *(const f32x4*)(X + (size_t)m * DM + 256 * j + 4 * F.lane); ss += (v[j][0] * v[j][0] + v[j][1] * v[j][1]) + (v[j][2] * v[j][2] + v[j][3] * v[j][3]); }
            const float rstd = 1.0f / sqrtf(wave_sum(ss) * (1.0f / DM) + EPS);
#pragma unroll
            for (int j = 0; j < 4; ++j) { const f32x4 o = v[j] * rstd * g[j];
                hn[r][4 * j + 0] = o[0]; hn[r][4 * j + 1] = o[1]; hn[r][4 * j + 2] = o[2]; hn[r][4 * j + 3] = o[3];
                u32x2 w; w.x = pk2(o[0], o[1]); w.y = pk2(o[2], o[3]); *(u32x2*)(XN + (size_t)m * DM + 256 * j + 4 * F.lane) = w; } }
        float acc[RB][16];
#pragma unroll
        for (int r = 0; r < RB; ++r)
#pragma unroll
            for (int e = 0; e < 16; ++e) acc[r][e] = 0.f;
#pragma unroll
        for (int j = 0; j < 4; ++j)
#pragma unroll
            for (int c = 0; c < 4; ++c) { const int k = 256 * j + 4 * F.lane + c; asm volatile("" ::: "memory");
                f32x4 w4[4];
#pragma unroll
                for (int q = 0; q < 4; ++q) w4[q] = *(const LAS f32x4*)(RW + k * 16 + 4 * q);
#pragma unroll
                for (int r = 0; r < RB; ++r)
#pragma unroll
                    for (int e = 0; e < 16; ++e) acc[r][e] += hn[r][4 * j + c] * w4[e >> 2][e & 3];
#pragma unroll
                for (int r = 0; r < RB; ++r) asm volatile("" : "+v"(acc[r][0]), "+v"(acc[r][1]), "+v"(acc[r][2]), "+v"(acc[r][3]), "+v"(acc[r][4]), "+v"(acc[r][5]), "+v"(acc[r][6]), "+v"(acc[r][7]),
                    "+v"(acc[r][8]), "+v"(acc[r][9]), "+v"(acc[r][10]), "+v"(acc[r][11]), "+v"(acc[r][12]), "+v"(acc[r][13]), "+v"(acc[r][14]), "+v"(acc[r][15])); }
#pragma unroll
        for (int r = 0; r < RB; ++r)
#pragma unroll
            for (int e = 0; e < 16; ++e) { const float s = wave_sum(acc[r][e]); if (F.lane == 0) lsc[r * 16 + e] = s; }
        asm volatile("s_waitcnt lgkmcnt(0)" ::: "memory");
        if (F.lane < RB) {
            const int r = F.lane; LAS float* lg = lsc + r * 16;
            float best_gs = -1e30f; int best = 0;
#pragma unroll
            for (int gI = 0; gI < 4; ++gI) { float m1 = -1e30f, m2 = -1e30f;
#pragma unroll
                for (int i = 0; i < 4; ++i) { const float af = 1.0f / (1.0f + expf(-lg[4 * gI + i])); const float s = af + rb[4 * gI + i];
                    if (s > m1) { m2 = m1; m1 = s; } else if (s > m2) m2 = s; }
                const float gs = m1 + m2; if (gs > best_gs) { best_gs = gs; best = gI; } }
            float s1 = -1e30f, s2 = -1e30f; int i1 = 0, i2 = 0; float a1 = 0.f, a2 = 0.f;
#pragma unroll
            for (int i = 0; i < 4; ++i) { const float af = 1.0f / (1.0f + expf(-lg[4 * best + i])); const float s = af + rb[4 * best + i];
                if (s > s1) { s2 = s1; i2 = i1; a2 = a1; s1 = s; i1 = i; a1 = af; } else if (s > s2) { s2 = s; i2 = i; a2 = af; } }
            const int e0 = 4 * best + i1, e1 = 4 * best + i2; const float inv = 1.0f / (a1 + a2);
            const int lr = lr0 + r;
            tE[lr] = e0; tE[64 + lr] = e1; tW[lr] = a1 * inv; tW[64 + lr] = a2 * inv;
            tP[lr] = atomicAdd((int*)&lcnt[e0], 1); tP[64 + lr] = atomicAdd((int*)&lcnt[e1], 1);
        }
    }
    __syncthreads();
    if (F.tid < 16) gbase[F.tid] = (int)__hip_atomic_fetch_add((unsigned*)(F.ctl + CW_CNT + 64 * l + F.tid), (unsigned)lcnt[F.tid], __ATOMIC_RELAXED, __HIP_MEMORY_SCOPE_AGENT);
    __syncthreads();
    if (F.tid < 2 * rows_per_wg) { const int slot = F.tid / rows_per_wg, lr = F.tid % rows_per_wg; const int e = tE[slot * 64 + lr]; const int pos = gbase[e] + tP[slot * 64 + lr];
        LIST[(size_t)e * LISTCAP + pos] = (unsigned)(row0 + lr) | ((unsigned)slot << 31); WL[(size_t)e * LISTCAP + pos] = tW[slot * 64 + lr]; }
    __syncthreads();
}

__device__ __forceinline__ void gmlp_unit(const Frame& F_, ArgsP a, int l, int unit) {
    const Frame F = phase_frame(F_);
    constexpr int VST = 320;
    const int c = unit >> 2, g = unit & 3; const int t0 = c * 128;
    const bf16_t* PROJ = (const bf16_t*)(F.ws + WS_PROJ); bf16_t* YA = (bf16_t*)(F.ws + WS_Y);
    LAS unsigned char* gv = F.lds; LAS float* rs = (LAS float*)(F.lds + 40960);
    {
        const int row = F.tid >> 2, qt = F.tid & 3; const bf16_t* p = PROJ + (size_t)(t0 + row) * INW + C_VA + qt * 128; float ss = 0.f;
#pragma unroll
        for (int i = 0; i < 16; ++i) { const u32x4 w = *(const u32x4*)(p + 8 * i);
            ss += bf_lo(w.x) * bf_lo(w.x) + bf_hi(w.x) * bf_hi(w.x) + bf_lo(w.y) * bf_lo(w.y) + bf_hi(w.y) * bf_hi(w.y) + bf_lo(w.z) * bf_lo(w.z) + bf_hi(w.z) * bf_hi(w.z) + bf_lo(w.w) * bf_lo(w.w) + bf_hi(w.w) * bf_hi(w.w); }
        ss += xor1_f(ss); ss += xor2_f(ss);
        if (qt == 0) rs[row] = 1.0f / sqrtf(ss * (1.0f / 512.0f) + EPS);
#pragma unroll
        for (int j = 0; j < 4; ++j) { const int id = F.tid + 512 * j, r = id >> 4, ch = id & 15;
            *(LAS u32x4*)(gv + r * VST + ch * 16) = *(const u32x4*)(PROJ + (size_t)(t0 + r) * INW + C_VA + g * 128 + ch * 8); }
    }
    __syncthreads();
    const int wt = F.wave >> 1, dh = F.wave & 1, r32 = F.lane & 31, hh = F.lane >> 5;
    const int q4 = (F.lane & 15) >> 2, p4 = F.lane & 3, blk = (F.lane >> 4) & 1;
    const int tl = 32 * wt + r32;
    gfp wrow = GIN(I_WS) + (((size_t)l * 4 + g) * 128 + tl) * 128;
    f32x16 acc[2]; acc[0] = f32x16{}; acc[1] = f32x16{};
    for (int ks = 0; ks < 8; ++ks) {
        if (16 * ks > 32 * wt + 31) break;
        const int s0 = 16 * ks + 8 * hh;
        const f32x4 w0 = *(const GAS f32x4*)(wrow + s0), w1 = *(const GAS f32x4*)(wrow + s0 + 4);
        const f32x4 r0 = *(const LAS f32x4*)(rs + s0), r1 = *(const LAS f32x4*)(rs + s0 + 4);
        float wv[8];
#pragma unroll
        for (int j = 0; j < 4; ++j) { wv[j] = (s0 + j <= tl) ? w0[j] * r0[j] : 0.f; wv[4 + j] = (s0 + 4 + j <= tl) ? w1[j] * r1[j] : 0.f; }
        u32x4 wp; wp.x = pk2(wv[0], wv[1]); wp.y = pk2(wv[2], wv[3]); wp.z = pk2(wv[4], wv[5]); wp.w = pk2(wv[6], wv[7]);
        const bf16x8 wfr = __builtin_bit_cast(bf16x8, wp);
#pragma unroll
        for (int di = 0; di < 2; ++di) { const int dt = 2 * dh + di;
            const s16x4 lo = vtr(gv + (16 * ks + 8 * hh + q4) * VST + 64 * dt + 32 * blk + 8 * p4);
            const s16x4 hi = vtr(gv + (16 * ks + 8 * hh + 4 + q4) * VST + 64 * dt + 32 * blk + 8 * p4);
            const bf16x8 gfr = __builtin_shufflevector(lo, hi, 0, 1, 2, 3, 4, 5, 6, 7);
            acc[di] = MFMA32(gfr, wfr, acc[di]); }
    }
    const float bias = GIN(I_BS)[((size_t)l * 4 + g) * 128 + tl];
    gfp gvg = GIN(I_GV) + (size_t)l * 512 + g * 128;
    const bf16_t* urow = PROJ + (size_t)(t0 + tl) * INW + C_UA + g * 128; bf16_t* yrow = YA + (size_t)(t0 + tl) * 512 + g * 128;
#pragma unroll
    for (int di = 0; di < 2; ++di)
#pragma unroll
        for (int G4 = 0; G4 < 4; ++G4) { const int d = 32 * (2 * dh + di) + 8 * G4 + 4 * hh;
            const f32x4 gg = *(const GAS f32x4*)(gvg + d); const u32x2 uu = *(const u32x2*)(urow + d);
            const float o0 = bf_lo(uu.x) * (acc[di][4 * G4 + 0] * gg[0] + bias), o1 = bf_hi(uu.x) * (acc[di][4 * G4 + 1] * gg[1] + bias);
            const float o2 = bf_lo(uu.y) * (acc[di][4 * G4 + 2] * gg[2] + bias), o3 = bf_hi(uu.y) * (acc[di][4 * G4 + 3] * gg[3] + bias);
            u32x2 w; w.x = pk2(o0, o1); w.y = pk2(o2, o3); *(u32x2*)(yrow + d) = w; }
    __syncthreads();
}

__device__ __forceinline__ void sb_unit(const Frame& F_, int unit) {
    const Frame F = phase_frame(F_);
    constexpr int KST = 144, VST = 192, BUFB = 9216 + 12288;
    const int b = unit >> 7, h = (unit >> 4) & 7, qb = unit & 15;
    const bf16_t* PROJ = (const bf16_t*)(F.ws + WS_PROJ); bf16_t* YC = (bf16_t*)(F.ws + WS_Y) + (size_t)2 * T * 512;
    const size_t rowbase = (size_t)b * SEQ; const int q0 = qb * 256;
    const int r32 = F.lane & 31, hh = F.lane >> 5, q4 = (F.lane & 15) >> 2, p4 = F.lane & 3, blk = (F.lane >> 4) & 1;
    const int qa = q0 + 32 * F.wave, qpos = qa + r32;
    bf16x8 qf[4];
#pragma unroll
    for (int ks = 0; ks < 4; ++ks) qf[ks] = *(const bf16x8*)(PROJ + (rowbase + qpos) * INW + C_QC + h * 64 + 16 * ks + 8 * hh);
    const int srow = F.tid >> 3, sch = F.tid & 7;
    const bf16_t* ksrc = PROJ + (rowbase + srow) * INW + C_KC + h * 64 + sch * 8;
    const bf16_t* vsrc = PROJ + (rowbase + srow) * INW + C_VC + h * 64 + sch * 8;
    const int kdst = srow * KST + sch * 16, vdst = 9216 + srow * VST + sch * 16;
    f32x16 o[2]; o[0] = f32x16{}; o[1] = f32x16{};
    float carry = 0.f; bool done = false;
    const int kt_hi = (q0 + 255) >> 6;
    u32x4 kreg = *(const u32x4*)(ksrc + (size_t)kt_hi * 64 * INW), vreg = *(const u32x4*)(vsrc + (size_t)kt_hi * 64 * INW);
    *(LAS u32x4*)(F.lds + kdst) = kreg; *(LAS u32x4*)(F.lds + vdst) = vreg;
    __syncthreads();
    int buf = 0;
    for (int kt = kt_hi; kt >= 0; --kt) {
        const int k0 = kt * 64;
        const bool more = (kt > 0);
        if (more) { kreg = *(const u32x4*)(ksrc + (size_t)(kt - 1) * 64 * INW); vreg = *(const u32x4*)(vsrc + (size_t)(kt - 1) * 64 * INW); }
        LAS unsigned char* Kb = F.lds + buf * BUFB; LAS unsigned char* Vb = Kb + 9216;
        if (!done && k0 < qa + 31) {
#pragma unroll
            for (int sub = 1; sub >= 0; --sub) {
                const int kb0 = k0 + 32 * sub;
                if (kb0 < qa + 31) {
                    f32x16 sacc = f32x16{};
#pragma unroll
                    for (int ks = 0; ks < 4; ++ks) { const bf16x8 kfr = *(const LAS bf16x8*)(Kb + (32 * sub + r32) * KST + (16 * ks + 8 * hh) * 2); sacc = MFMA32(kfr, qf[ks], sacc); }
                    float lk[16], lb[16];
#pragma unroll
                    for (int r = 0; r < 16; ++r) { const float z2 = sacc[r] * (0.125f * LOG2E); const float sp2 = fmaxf(z2, 0.f) + flog2(1.0f + fexp2(-fabsf(z2)));
                        const bool valid = (kb0 + crow(r, hh)) < qpos; lk[r] = valid ? -sp2 : 0.f; lb[r] = valid ? (z2 - sp2) : -1e30f; }
                    float gs[4], og[4];
#pragma unroll
                    for (int G4 = 0; G4 < 4; ++G4) { gs[G4] = (lk[4 * G4] + lk[4 * G4 + 1]) + (lk[4 * G4 + 2] + lk[4 * G4 + 3]); og[G4] = other_half(gs[G4], hh); }
                    float hi_sum = 0.f;
                    float av[16];
#pragma unroll
                    for (int G4 = 3; G4 >= 0; --G4) {
                        float suf = carry + hi_sum + (hh == 0 ? og[G4] : 0.f);
#pragma unroll
                        for (int cI = 3; cI >= 0; --cI) { av[4 * G4 + cI] = fexp2(lb[4 * G4 + cI] + suf); suf += lk[4 * G4 + cI]; }
                        hi_sum += gs[G4] + og[G4];
                    }
                    carry += hi_sum;
#pragma unroll
                    for (int s = 0; s < 2; ++s) {
                        u32x4 pw; pw.x = pk2(av[8 * s + 0], av[8 * s + 1]); pw.y = pk2(av[8 * s + 2], av[8 * s + 3]); pw.z = pk2(av[8 * s + 4], av[8 * s + 5]); pw.w = pk2(av[8 * s + 6], av[8 * s + 7]);
                        const bf16x8 pa = __builtin_bit_cast(bf16x8, pw);
#pragma unroll
                        for (int dt = 0; dt < 2; ++dt) {
                            const s16x4 lo = vtr(Vb + (32 * sub + 16 * s + 4 * hh + q4) * VST + 64 * dt + 32 * blk + 8 * p4);
                            const s16x4 hi = vtr(Vb + (32 * sub + 16 * s + 8 + 4 * hh + q4) * VST + 64 * dt + 32 * blk + 8 * p4);
                            const bf16x8 vfr = __builtin_shufflevector(lo, hi, 0, 1, 2, 3, 4, 5, 6, 7);
                            o[dt] = MFMA32(vfr, pa, o[dt]); }
                    }
                }
            }
            if (__all(carry < -45.0f)) done = true;
        }
        if (kt == 0) done = true;
        if (more) { *(LAS u32x4*)(F.lds + (buf ^ 1) * BUFB + kdst) = kreg; *(LAS u32x4*)(F.lds + (buf ^ 1) * BUFB + vdst) = vreg; }
        volatile LAS unsigned* fl = (volatile LAS unsigned*)(F.lds + MISC_OFF + 512) + ((kt & 1) << 3);
        if (F.lane == 0) fl[F.wave] = done ? 0u : 1u;
        __syncthreads();
        const unsigned any_left = (fl[0] | fl[1]) | (fl[2] | fl[3]) | (fl[4] | fl[5]) | (fl[6] | fl[7]);
        buf ^= 1;
        if (!any_left) break;
    }
    bf16_t* yrow = YC + (rowbase + qpos) * 512 + h * 64;
#pragma unroll
    for (int dt = 0; dt < 2; ++dt)
#pragma unroll
        for (int G4 = 0; G4 < 4; ++G4) { u32x2 w; w.x = pk2(o[dt][4 * G4], o[dt][4 * G4 + 1]); w.y = pk2(o[dt][4 * G4 + 2], o[dt][4 * G4 + 3]);
            *(u32x2*)(yrow + 32 * dt + 8 * G4 + 4 * hh) = w; }
    __syncthreads();
}

__device__ __forceinline__ void da_unit(const Frame& F_, ArgsP a, int l, int b, int h, int qblk) {
    const Frame F = phase_frame(F_);
    constexpr int KST = 144, VST = 320, BUFB = 2 * 9216 + 20480;
    const bf16_t* PROJ = (const bf16_t*)(F.ws + WS_PROJ); bf16_t* YB = (bf16_t*)(F.ws + WS_Y) + (size_t)T * 512;
    const size_t rowbase = (size_t)b * SEQ; const int q0 = qblk * 128;
    const int map = F.wave >> 2, wq = F.wave & 3;
    const int r32 = F.lane & 31, hh = F.lane >> 5, q4 = (F.lane & 15) >> 2, p4 = F.lane & 3, blk = (F.lane >> 4) & 1;
    const int qa = q0 + 32 * wq, qpos = qa + r32;
    const float slope = (h == 0) ? 0.25f : (h == 1) ? 0.0625f : (h == 2) ? 0.015625f : 0.00390625f;
    const float c1 = 0.125f * LOG2E, c2 = slope * LOG2E;
    bf16x8 qf[4];
#pragma unroll
    for (int ks = 0; ks < 4; ++ks) qf[ks] = *(const bf16x8*)(PROJ + (rowbase + qpos) * INW + C_QB + h * 128 + map * 64 + 16 * ks + 8 * hh);
    const int srow = F.tid >> 3, sch = F.tid & 7;
    const bf16_t* ksrc = PROJ + (rowbase + srow) * INW + C_KB + h * 128 + sch * 8;
    const bf16_t* vsrc = PROJ + (rowbase + srow) * INW + C_VB + h * 128 + sch * 8;
    const int k0dst = srow * KST + sch * 16, k1dst = 9216 + k0dst, vdst = 18432 + srow * VST + sch * 16;
    f32x16 o[4]; o[0] = f32x16{}; o[1] = f32x16{}; o[2] = f32x16{}; o[3] = f32x16{};
    float m_run = -1e30f, l_run = 0.f;
    const int kt_hi = (q0 + 127) >> 6;
    u32x4 kr0 = *(const u32x4*)(ksrc + (size_t)kt_hi * 64 * INW), kr1 = *(const u32x4*)(ksrc + (size_t)kt_hi * 64 * INW + 64);
    u32x4 vr0 = *(const u32x4*)(vsrc + (size_t)kt_hi * 64 * INW), vr1 = *(const u32x4*)(vsrc + (size_t)kt_hi * 64 * INW + 64);
    *(LAS u32x4*)(F.lds + k0dst) = kr0; *(LAS u32x4*)(F.lds + k1dst) = kr1; *(LAS u32x4*)(F.lds + vdst) = vr0; *(LAS u32x4*)(F.lds + vdst + 128) = vr1;
    __syncthreads();
    int buf = 0;
    for (int kt = kt_hi; kt >= 0; --kt) {
        const int k0 = kt * 64;
        const bool more = (kt > 0);
        if (more) { const size_t off = (size_t)(kt - 1) * 64 * INW; kr0 = *(const u32x4*)(ksrc + off); kr1 = *(const u32x4*)(ksrc + off + 64); vr0 = *(const u32x4*)(vsrc + off); vr1 = *(const u32x4*)(vsrc + off + 64); }
        LAS unsigned char* Kb = F.lds + buf * BUFB + map * 9216; LAS unsigned char* Vb = F.lds + buf * BUFB + 18432;
        if (k0 <= qa + 31) {
            float s[2][16];
            const bool sub1 = (k0 + 32 <= qa + 31);
#pragma unroll
            for (int sub = 0; sub < 2; ++sub) {
                if (sub == 0 || sub1) {
                    f32x16 sacc = f32x16{};
#pragma unroll
                    for (int ks = 0; ks < 4; ++ks) { const bf16x8 kfr = *(const LAS bf16x8*)(Kb + (32 * sub + r32) * KST + (16 * ks + 8 * hh) * 2); sacc = MFMA32(kfr, qf[ks], sacc); }
#pragma unroll
                    for (int r = 0; r < 16; ++r) { const int kpos = k0 + 32 * sub + crow(r, hh); const int dist = qpos - kpos;
                        s[sub][r] = (dist >= 0) ? (sacc[r] * c1 - c2 * (float)dist) : -1e30f; }
                } else {
#pragma unroll
                    for (int r = 0; r < 16; ++r) s[sub][r] = -1e30f;
                }
            }
            float mx = s[0][0];
#pragma unroll
            for (int r = 1; r < 16; ++r) mx = fmaxf(mx, s[0][r]);
#pragma unroll
            for (int r = 0; r < 16; ++r) mx = fmaxf(mx, s[1][r]);
            mx = fmaxf(mx, other_half(mx, hh));
            const float mnew = fmaxf(m_run, mx);
            if (__any(mnew > m_run)) { const float al = fexp2(m_run - mnew); l_run *= al;
#pragma unroll
                for (int dt = 0; dt < 4; ++dt)
#pragma unroll
                    for (int r = 0; r < 16; ++r) o[dt][r] *= al;
                m_run = mnew; }
            float psum = 0.f;
#pragma unroll
            for (int sub = 0; sub < 2; ++sub)
#pragma unroll
                for (int r = 0; r < 16; ++r) { s[sub][r] = fexp2(s[sub][r] - m_run); psum += s[sub][r]; }
            l_run += psum;
#pragma unroll
            for (int sub = 0; sub < 2; ++sub) {
                if (sub == 0 || sub1) {
#pragma unroll
                    for (int st = 0; st < 2; ++st) {
                        u32x4 pw; pw.x = pk2(s[sub][8 * st + 0], s[sub][8 * st + 1]); pw.y = pk2(s[sub][8 * st + 2], s[sub][8 * st + 3]); pw.z = pk2(s[sub][8 * st + 4], s[sub][8 * st + 5]); pw.w = pk2(s[sub][8 * st + 6], s[sub][8 * st + 7]);
                        const bf16x8 pa = __builtin_bit_cast(bf16x8, pw);
#pragma unroll
                        for (int dt = 0; dt < 4; ++dt) {
                            const s16x4 lo = vtr(Vb + (32 * sub + 16 * st + 4 * hh + q4) * VST + 64 * dt + 32 * blk + 8 * p4);
                            const s16x4 hi = vtr(Vb + (32 * sub + 16 * st + 8 + 4 * hh + q4) * VST + 64 * dt + 32 * blk + 8 * p4);
                            const bf16x8 vfr = __builtin_shufflevector(lo, hi, 0, 1, 2, 3, 4, 5, 6, 7);
                            o[dt] = MFMA32(vfr, pa, o[dt]); }
                    }
                }
            }
        }
        if (more) { LAS unsigned char* nb = F.lds + (buf ^ 1) * BUFB; *(LAS u32x4*)(nb + k0dst) = kr0; *(LAS u32x4*)(nb + k1dst) = kr1; *(LAS u32x4*)(nb + vdst) = vr0; *(LAS u32x4*)(nb + vdst + 128) = vr1; }
        __syncthreads();
        buf ^= 1;
    }
    const float ltot = l_run + other_half(l_run, hh); const float linv = 1.0f / ltot;
    LAS float* ex = (LAS float*)F.lds;
    if (map == 1) {
#pragma unroll
        for (int dt = 0; dt < 4; ++dt)
#pragma unroll
            for (int r = 0; r < 16; ++r) ex[((wq * 4 + dt) * 16 + r) * 64 + F.lane] = o[dt][r] * linv;
    }
    __syncthreads();
    if (map == 0) {
        gfp lp = GIN(I_LAM) + (size_t)l * 256;
        const float d1 = wave_sum(lp[F.lane] * lp[64 + F.lane]), d2 = wave_sum(lp[128 + F.lane] * lp[192 + F.lane]);
        const float lam = expf(d1) - expf(d2) + a->lam_init[l];
        float ss = 0.f;
#pragma unroll
        for (int dt = 0; dt < 4; ++dt)
#pragma unroll
            for (int r = 0; r < 16; ++r) { const float v = o[dt][r] * linv - lam * ex[((wq * 4 + dt) * 16 + r) * 64 + F.lane]; o[dt][r] = v; ss += v * v; }
        ss += other_half(ss, hh);
        const float sc = (1.0f / sqrtf(ss * (1.0f / 128.0f) + EPS)) * (1.0f - a->lam_init[l]);
        gfp sg = GIN(I_SUBLN) + (size_t)l * 128;
        bf16_t* yrow = YB + (rowbase + qpos) * 512 + h * 128;
#pragma unroll
        for (int dt = 0; dt < 4; ++dt)
#pragma unroll
            for (int G4 = 0; G4 < 4; ++G4) { const int d = 32 * dt + 8 * G4 + 4 * hh; const f32x4 gg = *(const GAS f32x4*)(sg + d);
                u32x2 w; w.x = pk2(o[dt][4 * G4] * sc * gg[0], o[dt][4 * G4 + 1] * sc * gg[1]); w.y = pk2(o[dt][4 * G4 + 2] * sc * gg[2], o[dt][4 * G4 + 3] * sc * gg[3]);
                *(u32x2*)(yrow + d) = w; }
    }
    __syncthreads();
}

__device__ __forceinline__ void mixer_phase(Frame& F, ArgsP a, int l) {
    for (int u = F.vcu; u < 256; u += F.G) { const int bh = u >> 4, p = u & 15; da_unit(F, a, l, bh >> 2, bh & 3, 31 - p); da_unit(F, a, l, bh >> 2, bh & 3, p); }
    for (int u = F.vcu; u < 512; u += F.G) sb_unit(F, u);
    for (int u = F.vcu; u < 512; u += F.G) gmlp_unit(F, a, l, u);
}

constexpr int PH_PER_LAYER = 8, N_PHASES = DEPTH * PH_PER_LAYER + 1;
__global__ void __launch_bounds__(NTHREADS, 2) fwd_kernel(Args args) {
    extern __shared__ __attribute__((aligned(16))) unsigned char lds_raw[];
    Frame F;
    F.lds = (LAS unsigned char*)lds_raw;
    F.tid = threadIdx.x; F.lane = F.tid & 63; F.wave = __builtin_amdgcn_readfirstlane(F.tid >> 6);
    F.G = gridDim.x; { const int bx = blockIdx.x; F.vcu = (F.G % 8 == 0) ? (bx % 8) * (F.G / 8) + bx / 8 : bx; }
    F.ws = args.ws; F.ctl = (gu32*)(args.ws + WS_CTL);
    volatile LAS unsigned* MISC = (volatile LAS unsigned*)(F.lds + MISC_OFF);
    for (int u = F.tid; u < 256; u += NTHREADS) MISC[u] = 0u;
    __syncthreads();
#if MK_MULTI
#define GRID_BAR() do { } while (0)
#else
    XcdBarrier bar = xcd_barrier_post((unsigned*)(F.ctl + CW_BAR), MISC + 8);
#define GRID_BAR() xcd_barrier(bar)
#endif
    const int lo = args.ph_lo, hi = args.ph_hi;
#ifndef PHASE_MASK
#define PHASE_MASK 0x1ff
#endif
#define IN(k) (lo <= (k) && (k) < hi && ((PHASE_MASK >> ((k) % PH_PER_LAYER + ((k) == DEPTH * PH_PER_LAYER ? 8 : 0))) & 1))
#define SEAM(k) do { if (IN((k) + 1)) GRID_BAR(); } while (0)
    const Frame F0 = F;
    ArgsP args_p;
    LAS int* const PFX = (LAS int*)(F.lds + MISC_OFF + 1024);
    LAS int* const CNT = (LAS int*)(F.lds + MISC_OFF + 1024 + 4 * 192);
    for (int l = 0; l < DEPTH; ++l) {
        const int p0 = l * PH_PER_LAYER;
        F = phase_frame(F0);
        { ArgsP ap = (ArgsP)__builtin_amdgcn_kernarg_segment_ptr(); asm volatile("" : "+s"(ap)); args_p = ap; }
        int bx = blockIdx.x; asm volatile("" : "+s"(bx));
        bf16_t* const Wb = (bf16_t*)(F.ws + WS_W);
        bf16_t* const ACT = (bf16_t*)(F.ws + WS_ACT);
        bf16_t* const PROJ = (bf16_t*)(F.ws + WS_PROJ);
        bf16_t* const Y = (bf16_t*)(F.ws + WS_Y);
        if (IN(p0 + 0)) { convert_weights(F, args_p, l); if (l == 0) norm_rows<0>(F, args_p, l); else norm_rows<1>(F, args_p, l); SEAM(p0 + 0); }
        if (IN(p0 + 1)) { pg8::DenseOrder S; S.init(T, INW, DM, Wb + W_IN / 2, F.G, bx); pg8::EpiProj E{PROJ};
            pg8::gemm_phase<pg8::EpiProj, pg8::DenseOrder, true>(F.lds, F.wave, ACT, DM, S, E); SEAM(p0 + 1); }
        if (IN(p0 + 2)) { mixer_phase(F, args_p, l); SEAM(p0 + 2); }
        if (IN(p0 + 3)) {
            { pg8::DenseOrder S; S.init(T, DM, 512, Wb + W_UP / 2, F.G, bx); pg8::EpiGate<true> E{ACT, PROJ + C_G};
              pg8::gemm_phase<pg8::EpiGate<true>, pg8::DenseOrder, false>(F.lds, F.wave, Y, 512, S, E); }
            { pg8::DenseOrder S; S.init(T, DM, 512, Wb + W_UP / 2 + (size_t)DM * 512, F.G, bx); pg8::EpiGate<false> E{ACT, PROJ + C_G + 1024};
              pg8::gemm_phase<pg8::EpiGate<false>, pg8::DenseOrder, false>(F.lds, F.wave, Y + (size_t)T * 512, 512, S, E); }
            { pg8::DenseOrder S; S.init(T, DM, 512, Wb + W_UP / 2 + (size_t)2 * DM * 512, F.G, bx); pg8::EpiGate<false> E{ACT, PROJ + C_G + 2048};
              pg8::gemm_phase<pg8::EpiGate<false>, pg8::DenseOrder, false>(F.lds, F.wave, Y + (size_t)2 * T * 512, 512, S, E); }
            SEAM(p0 + 3); }
        if (IN(p0 + 4)) { pg8::DenseOrder S; S.init(T, DM, DM, Wb + W_OUT / 2, F.G, bx); pg8::EpiRes E{(float*)(F.ws + WS_X)};
            pg8::gemm_phase<pg8::EpiRes, pg8::DenseOrder, false>(F.lds, F.wave, ACT, DM, S, E); SEAM(p0 + 4); }
        if (IN(p0 + 5)) { t2_phase(F, args_p, l); SEAM(p0 + 5); }
        if (IN(p0 + 6) || IN(p0 + 7)) {
            if (F.tid == 0) { int run = 0;
                for (int e = 0; e < NE; ++e) { const int c = (int)__hip_atomic_load((unsigned*)(F.ctl + CW_CNT + 64 * l + e), __ATOMIC_RELAXED, __HIP_MEMORY_SCOPE_AGENT); CNT[e] = c; PFX[e] = run; run += (c + 255) >> 8; }
                PFX[16] = run; }
            __syncthreads();
            if (F.tid < 160) { int e = 0;
#pragma unroll
                for (int j = 1; j < 16; ++j) e += (PFX[j] <= F.tid) ? 1 : 0;
                PFX[32 + F.tid] = e; }
            __syncthreads();
        }
        if (IN(p0 + 6)) { MoeOrder<true> S{F.G, bx, 4, PFX, CNT, Wb + W_13 / 2, (size_t)DM * DM * 2, DM, (const unsigned*)(F.ws + WS_LIST)};
            pg8::EpiMoe1 E{(bf16_t*)(F.ws + WS_H), (const float*)(F.ws + WS_WL)};
            pg8::gemm_phase<pg8::EpiMoe1, MoeOrder<true>, true, true>(F.lds, F.wave, ACT, DM, S, E); SEAM(p0 + 6); }
        if (IN(p0 + 7)) { MoeOrder<false> S{F.G, bx, 4, PFX, CNT, Wb + W_2 / 2, (size_t)DM * DFF * 2, DFF, (const unsigned*)(F.ws + WS_LIST)};
            pg8::EpiMoe2 E{(bf16_t*)(F.ws + WS_YS), (const unsigned*)(F.ws + WS_LIST)};
            pg8::gemm_phase<pg8::EpiMoe2, MoeOrder<false>, true>(F.lds, F.wave, (const bf16_t*)(F.ws + WS_H), DFF, S, E); SEAM(p0 + 7); }
    }
    F = phase_frame(F0);
    { ArgsP ap = (ArgsP)__builtin_amdgcn_kernarg_segment_ptr(); asm volatile("" : "+s"(ap)); args_p = ap; }
    if (IN(DEPTH * PH_PER_LAYER)) norm_rows<2>(F, args_p, 0);
#undef IN
#undef SEAM
}

extern "C" void kernel_launch(void* const* d_in, const int* in_sizes, int n_in, void* d_out, int out_size, void* d_ws, size_t ws_size, hipStream_t stream) {
    static int grid = 0;
    if (grid == 0) {
        if (n_in != 19 || in_sizes[0] != T * DM || out_size != T * DM || ws_size < WS_END) { fprintf(stderr, "kernel_launch: unexpected shapes / workspace (n_in %d, ws %zu); nothing launched\n", n_in, ws_size); grid = -1; return; }
        int dev = 0, cus = 0, per_cu = 0;
        if (hipGetDevice(&dev) != hipSuccess || hipDeviceGetAttribute(&cus, hipDeviceAttributeMultiprocessorCount, dev) != hipSuccess) { grid = -1; return; }
        if (hipFuncSetAttribute((const void*)fwd_kernel, hipFuncAttributeMaxDynamicSharedMemorySize, LDS_BYTES) != hipSuccess) { fprintf(stderr, "kernel_launch: hipFuncSetAttribute failed\n"); grid = -1; return; }
        if (hipOccupancyMaxActiveBlocksPerMultiprocessor(&per_cu, (const void*)fwd_kernel, NTHREADS, LDS_BYTES) != hipSuccess || per_cu < 1) fprintf(stderr, "kernel_launch: occupancy query reports %d\n", per_cu);
        (void)hipGetLastError();
        grid = cus;
        if (grid != 256) { fprintf(stderr, "kernel_launch: built for 256 CUs, found %d\n", cus); grid = -1; return; }
    }
    if (grid < 0) return;
    if (hipMemsetAsync((char*)d_ws + WS_CTL, 0, CTL_ZERO_BYTES, stream) != hipSuccess) return;
    Args a{};
    for (int i = 0; i < 19; ++i) a.in[i] = (const float*)d_in[i];
    a.out = (float*)d_out; a.ws = (unsigned char*)d_ws;
    for (int l = 0; l < DEPTH; ++l) a.lam_init[l] = (float)(0.8 - 0.6 * exp(-0.3 * (double)l));
#if MK_MULTI
    for (int p = 0; p < N_PHASES; ++p) { a.ph_lo = p; a.ph_hi = p + 1; hipLaunchKernelGGL(fwd_kernel, dim3(grid), dim3(NTHREADS), LDS_BYTES, stream, a); }
#else
    a.ph_lo = 0; a.ph_hi = N_PHASES;
    hipLaunchKernelGGL(fwd_kernel, dim3(grid), dim3(NTHREADS), LDS_BYTES, stream, a);
#endif
}
```

```cpp
#include <hip/hip_runtime.h>
#include <cstdio>
#include <cstdint>
#include <cmath>

#ifndef MK_MULTI
#define MK_MULTI 0
#endif

#ifndef PROBE_DUP
#define PROBE_DUP -1
#endif
#define REP(k) for (int rep_ = 0; rep_ < ((PROBE_DUP == (k)) ? 2 : 1); ++rep_)
#define LAS __attribute__((address_space(3)))
#define GAS __attribute__((address_space(1)))
typedef unsigned short bf16_t;
typedef short bf16x8 __attribute__((ext_vector_type(8)));
typedef short s16x4 __attribute__((ext_vector_type(4)));
typedef float f32x2 __attribute__((ext_vector_type(2)));
typedef float f32x4 __attribute__((ext_vector_type(4)));
typedef float f32x16 __attribute__((ext_vector_type(16)));
typedef unsigned u32x2 __attribute__((ext_vector_type(2)));
typedef unsigned u32x4 __attribute__((ext_vector_type(4)));
typedef GAS unsigned gu32;

constexpr int NBATCH = 4, SEQ = 4096, DM = 1024, T = NBATCH * SEQ, DEPTH = 4;
constexpr int INW = 7168, NE = 16, DFF = 512;
constexpr int C_UA = 0, C_VA = 512, C_QB = 1024, C_KB = 1536, C_VB = 2048, C_QC = 2560, C_KC = 3072, C_VC = 3584, C_G = 4096;
constexpr float EPS = 1e-6f;
constexpr float LOG2E = 1.4426950408889634f;
constexpr int NWAVES = 8, NTHREADS = 512;
constexpr int LISTCAP = T;

constexpr size_t MiB = 1u << 20;
constexpr size_t WS_CTL = 0, CTL_ZERO_BYTES = 1 * MiB;
constexpr size_t WS_LIST = 1 * MiB;
constexpr size_t WS_WL = 2 * MiB;
constexpr size_t WS_W = 4 * MiB;
constexpr size_t W_IN = 0, W_UP = 14 * MiB, W_OUT = 17 * MiB, W_13 = 19 * MiB, W_2 = 51 * MiB, W_END = 67 * MiB;
constexpr size_t WS_X = 72 * MiB;
constexpr size_t WS_ACT = 136 * MiB;
constexpr size_t WS_Y = 168 * MiB;
constexpr size_t WS_PROJ = 216 * MiB;
constexpr size_t WS_H = WS_PROJ;
constexpr size_t WS_YS = WS_PROJ + 40 * MiB;
constexpr size_t WS_END = 440 * MiB;
constexpr int CW_BAR = 4096;
constexpr int CW_CNT = 16384;
constexpr int CW_ERR = 8;
constexpr int CW_KMAX = 17408;
constexpr int CW_Q = 17920;

constexpr int RING_BYTES = 131072;
constexpr int MISC_OFF = RING_BYTES;
constexpr int LDS_BYTES = 147456;

__device__ __forceinline__ unsigned pk2(float lo, float hi) { typedef __bf16 b2 __attribute__((ext_vector_type(2))); f32x2 v = {lo, hi}; b2 b = __builtin_convertvector(v, b2); return __builtin_bit_cast(unsigned, b); }
__device__ __forceinline__ float bf_lo(unsigned w) { return __uint_as_float(w << 16); }
__device__ __forceinline__ float bf_hi(unsigned w) { return __uint_as_float(w & 0xffff0000u); }
template <int CTRL> __device__ __forceinline__ float dpp_f(float v) { return __builtin_bit_cast(float, __builtin_amdgcn_update_dpp(0, __builtin_bit_cast(int, v), CTRL, 0xf, 0xf, true)); }
__device__ __forceinline__ float xor1_f(float v) { return dpp_f<0xB1>(v); }
__device__ __forceinline__ float xor2_f(float v) { return dpp_f<0x4E>(v); }
__device__ __forceinline__ float wave_sum(float v) {
    v += dpp_f<0xB1>(v); v += dpp_f<0x4E>(v); v += dpp_f<0x141>(v)  ; v += dpp_f<0x140>(v)  ;
    v += __builtin_bit_cast(float, __builtin_amdgcn_ds_swizzle(__builtin_bit_cast(int, v), 0x401F))  ;
    auto rr = __builtin_amdgcn_permlane32_swap(__float_as_uint(v), __float_as_uint(v), false, false);
    return __uint_as_float(rr[0]) + __uint_as_float(rr[1]);
}
__device__ __forceinline__ float other_half(float v, int hh) { auto rr = __builtin_amdgcn_permlane32_swap(__float_as_uint(v), __float_as_uint(v), false, false); return __uint_as_float(hh ? rr[0] : rr[1]); }
__device__ __forceinline__ float fexp2(float x) { return __builtin_amdgcn_exp2f(x); }
__device__ __forceinline__ float flog2(float x) { return __builtin_amdgcn_logf(x); }
__device__ __forceinline__ float frcp(float x) { return __builtin_amdgcn_rcpf(x); }
__device__ __forceinline__ float gelu_tanh(float x) { const float u = x * (1.0f + 0.044715f * x * x); return x * frcp(1.0f + fexp2(-2.3022081985f * u)); }
__device__ __forceinline__ float sigmoidf_(float x) { return frcp(1.0f + fexp2(-LOG2E * x)); }
__device__ __forceinline__ int crow(int r, int hi) { return (r & 3) + 8 * (r >> 2) + 4 * hi; }
typedef short v4i16_t __attribute__((ext_vector_type(4)));
__device__ __forceinline__ s16x4 vtr(LAS const unsigned char* p) { return __builtin_bit_cast(s16x4, __builtin_amdgcn_ds_read_tr16_b64_v4i16((LAS v4i16_t*)p)); }
#define MFMA32(a, b, c) __builtin_amdgcn_mfma_f32_32x32x16_bf16((a), (b), (c), 0, 0, 0)

namespace pg8 {
constexpr int BM = 256, BK = 64, HALF = 128, HTB = HALF * BK * 2, STAGE_BYTES = 8 * HTB, NXCD = 8, WGM = 8;
__host__ __device__ __forceinline__ int lds_byte(int r, int c) { const int st = (r >> 4) * 2 + (c >> 5), rr = r & 15, cc = c & 31, ob = rr * 64 + cc * 2; return st * 1024 + (ob ^ (((ob >> 9) & 1) << 5)); }
__host__ __device__ __forceinline__ void stage_rc(int b, int& R, int& C) { const int st = b / 1024, sb = b % 1024, swz = sb ^ (((sb >> 9) & 1) << 5); R = (st >> 1) * 16 + swz / 64; C = (st & 1) * 32 + (swz % 64) / 2; }
__host__ __device__ __forceinline__ int perm32(int rho) { const int n = rho >> 4, i = rho & 15; return 8 * (i >> 2) + 4 * n + (i & 3); }

struct Unit { int pm, pn; int e, base, n; };

struct DenseOrder {
    int nM, nN, nwg, G, c; const bf16_t* Bt; int K;
    __device__ void init(int M, int N, int K_, const bf16_t* Bt_, int G_, int c_) { nM = M / BM; nN = N / BM; nwg = nM * nN; G = G_; c = c_; Bt = Bt_; K = K_; }
    __device__ __forceinline__ bool next(int i, Unit& u) const {
        const long L = (long)i * G + c; if (L >= nwg) return false;
        int wgid = (int)L; { const int q = nwg / NXCD, r = nwg % NXCD, xcd = wgid % NXCD, off = wgid / NXCD; wgid = (xcd < r ? xcd * (q + 1) : r * (q + 1) + (xcd - r) * q) + off; }
        const int nig = WGM * nN, gid = wgid / nig, fm = gid * WGM, gsz = (nM - fm) < WGM ? (nM - fm) : WGM;
        u.pm = fm + ((wgid % nig) % gsz); u.pn = (wgid % nig) / gsz; u.e = 0; u.base = 0; u.n = 0; return true;
    }
    __device__ __forceinline__ const char* b_base(const Unit& u) const { return (const char*)Bt + (size_t)u.pn * (size_t)(BM * K * 2); }
    __device__ __forceinline__ unsigned a_row(const Unit& u, int r) const { return (unsigned)(u.pm * BM + r); }
};

template <class Epi, class Sched, bool ALIGN_EPI, bool GATHER = false>
__device__ __forceinline__ void gemm_phase(LAS unsigned char* lds, const int wave_id, const bf16_t* A, const int K, const Sched& S, const Epi& E) {
    int lane_ = (int)__builtin_amdgcn_mbcnt_hi(~0u, __builtin_amdgcn_mbcnt_lo(~0u, 0u)); asm volatile("" : "+v"(lane_));
    const int wid = wave_id, lane = lane_, tid = wid * 64 + lane, wr = wid >> 2, wc = wid & 3, fr = lane & 15, fq = lane >> 4;
    const int nt = K / BK;
    int RA[2], CA[2]; unsigned voffB[2], voffA[2];
#pragma unroll
    for (int i = 0; i < 2; ++i) { int R, C; stage_rc(tid * 16 + i * 8192, R, C); const int Rb = Epi::PERM ? ((R & ~31) + perm32(R & 31)) : R;
        RA[i] = R; CA[i] = C; voffB[i] = (unsigned)(Rb * K + C) * 2u; voffA[i] = (unsigned)(R * K + C) * 2u; }
    const size_t kstep = (size_t)(BK * 2);
    const size_t hstep = (size_t)HALF * K * 2;
    const size_t tstep = 2 * hstep;
    const unsigned ldsw = (unsigned)wid * 1024u;
    const int aoff = lds_byte(wr * 64 + fr, fq * 8), boff = lds_byte(wc * 32 + fr, fq * 8);
#define PG8_SA(b, h) (((b) * 2 + (h)) * HTB)
#define PG8_SB(b, h) ((4 + (b) * 2 + (h)) * HTB)
#define PG8_STAGE(bufoff, gbase, voff) do { _Pragma("unroll") for (int _i = 0; _i < 2; ++_i) \
        __builtin_amdgcn_global_load_lds((const unsigned*)((const char*)(gbase) + (voff)[_i]), (LAS unsigned*)(lds + (bufoff) + ldsw + _i * 8192), 16, 0, 0); } while (0)
#define PG8_LDA(dst, b, h) do { _Pragma("unroll") for (int m = 0; m < 4; ++m) _Pragma("unroll") for (int k = 0; k < 2; ++k) dst[m][k] = *(const LAS bf16x8*)(lds + PG8_SA(b, h) + aoff + m * 2048 + k * 1024); } while (0)
#define PG8_LDB(dst, b, h) do { _Pragma("unroll") for (int n = 0; n < 2; ++n) _Pragma("unroll") for (int k = 0; k < 2; ++k) dst[n][k] = *(const LAS bf16x8*)(lds + PG8_SB(b, h) + boff + n * 2048 + k * 1024); } while (0)
#define PG8_MMA(ai, bj, At, Bt) do { __builtin_amdgcn_s_setprio(1); _Pragma("unroll") for (int m = 0; m < 4; ++m) _Pragma("unroll") for (int n = 0; n < 2; ++n) _Pragma("unroll") for (int k = 0; k < 2; ++k) \
        acc[ai][bj][m][n] = __builtin_amdgcn_mfma_f32_16x16x32_bf16(Bt[n][k], At[m][k], acc[ai][bj][m][n], 0, 0, 0); __builtin_amdgcn_s_setprio(0); } while (0)
#define PG8_WAIT_V(n) asm volatile("s_waitcnt vmcnt(" #n ")" ::: "memory")
#define PG8_WAIT_L(n) asm volatile("s_waitcnt lgkmcnt(" #n ")" ::: "memory")
#define PG8_BAR __builtin_amdgcn_s_barrier()
#define PG8_SCHED __builtin_amdgcn_sched_barrier(0)
#define PG8_STA(bufoff, kb, h, nx) do { if constexpr (GATHER) { _Pragma("unroll") for (int _i = 0; _i < 2; ++_i) \
        __builtin_amdgcn_global_load_lds((const unsigned*)(Ab + (kb) + ((nx) ? vN[h][_i] : vA[h][_i])), (LAS unsigned*)(lds + (bufoff) + ldsw + _i * 8192), 16, 0, 0); } \
        else { PG8_STAGE(bufoff, ((nx) ? nA : cA) + (kb) + (h) * hstep, voffA); } } while (0)
#define PG8_AOFFS(dst, u) do { _Pragma("unroll") for (int _h = 0; _h < 2; ++_h) _Pragma("unroll") for (int _i = 0; _i < 2; ++_i) \
        dst[_h][_i] = (S.a_row((u), _h * HALF + RA[_i]) * (unsigned)K + (unsigned)CA[_i]) * 2u; } while (0)
    Unit cur, nxt; int ui = 0;
    if (!S.next(0, cur)) return;
    f32x4 acc[2][2][4][2];
#pragma unroll
    for (int a = 0; a < 2; ++a)
#pragma unroll
        for (int b = 0; b < 2; ++b)
#pragma unroll
            for (int m = 0; m < 4; ++m)
#pragma unroll
                for (int n = 0; n < 2; ++n) acc[a][b][m][n] = (f32x4){0.f, 0.f, 0.f, 0.f};
    bf16x8 At[4][2], B0[2][2], B1[2][2];
    unsigned vA[2][2], vN[2][2];
    const char* const Ab = (const char*)A;
    const char* cA = Ab; const char* nA = Ab;
    if constexpr (GATHER) { PG8_AOFFS(vA, cur); } else { cA = Ab + (size_t)cur.pm * tstep; }
    const char* cB = S.b_base(cur);
    PG8_STAGE(PG8_SB(0, 0), cB, voffB); PG8_STAGE(PG8_SB(0, 1), cB + hstep, voffB); PG8_STA(PG8_SA(0, 0), 0, 0, false); PG8_STA(PG8_SA(0, 1), 0, 1, false);
    if (wr == 1) PG8_BAR;
    PG8_WAIT_V(2); PG8_BAR;
    PG8_STAGE(PG8_SB(1, 0), cB + kstep, voffB); PG8_STA(PG8_SA(1, 0), kstep, 0, false); PG8_STAGE(PG8_SB(1, 1), cB + hstep + kstep, voffB);
    PG8_WAIT_V(6); PG8_BAR;
    for (;;) {
        const bool has_next = S.next(ui + 1, nxt);
        if (!has_next) nxt = cur;
        if constexpr (GATHER) { PG8_AOFFS(vN, nxt); } else { nA = Ab + (size_t)nxt.pm * tstep; }
        const char* nB = has_next ? S.b_base(nxt) : cB;
        for (int t = 0; t < nt; t += 2) {
            const bool last = (t == nt - 2);
            const size_t k1 = (size_t)(t + 1) * kstep;
            const size_t k2 = last ? (size_t)0 : (size_t)(t + 2) * kstep; const char* b2 = last ? nB : cB + (size_t)(t + 2) * kstep;
            const size_t k3 = k2 + kstep; const char* b3 = b2 + kstep;
            PG8_LDB(B0, 0, 0); PG8_LDB(B1, 0, 1); PG8_SCHED; PG8_LDA(At, 0, 0); PG8_STA(PG8_SA(1, 1), k1, 1, false);
            PG8_WAIT_V(8); PG8_WAIT_L(0); PG8_BAR; PG8_MMA(0, 0, At, B0); PG8_MMA(0, 1, At, B1); PG8_BAR; PG8_SCHED;
            PG8_LDA(At, 0, 1); PG8_STAGE(PG8_SB(0, 0), b2, voffB); PG8_STAGE(PG8_SB(0, 1), b2 + hstep, voffB); PG8_STA(PG8_SA(0, 0), k2, 0, last);
            PG8_WAIT_V(8); PG8_WAIT_L(0); PG8_BAR; PG8_MMA(1, 0, At, B0); PG8_MMA(1, 1, At, B1); PG8_BAR; PG8_SCHED;
            PG8_LDB(B0, 1, 0); PG8_LDB(B1, 1, 1); PG8_SCHED; PG8_LDA(At, 1, 0); PG8_STA(PG8_SA(0, 1), k2, 1, last);
            PG8_WAIT_V(8); PG8_WAIT_L(0); PG8_BAR; PG8_MMA(0, 0, At, B0); PG8_MMA(0, 1, At, B1); PG8_BAR; PG8_SCHED;
            PG8_LDA(At, 1, 1); PG8_STAGE(PG8_SB(1, 0), b3, voffB); PG8_STAGE(PG8_SB(1, 1), b3 + hstep, voffB); PG8_STA(PG8_SA(1, 0), k3, 0, last);
            PG8_WAIT_V(8); PG8_WAIT_L(0); PG8_BAR; PG8_MMA(1, 0, At, B0); PG8_MMA(1, 1, At, B1); PG8_BAR; PG8_SCHED;
        }
        if constexpr (ALIGN_EPI) { if (wr == 0) PG8_BAR; }
        E(acc, cur, wr, wc, fr, fq);
        if (!has_next) break;
#pragma unroll
        for (int a = 0; a < 2; ++a)
#pragma unroll
            for (int b = 0; b < 2; ++b)
#pragma unroll
                for (int m = 0; m < 4; ++m)
#pragma unroll
                    for (int n = 0; n < 2; ++n) acc[a][b][m][n] = (f32x4){0.f, 0.f, 0.f, 0.f};
        cur = nxt; cB = nB; cA = nA; ++ui;
        if constexpr (GATHER) {
#pragma unroll
            for (int h = 0; h < 2; ++h)
#pragma unroll
                for (int i = 0; i < 2; ++i) vA[h][i] = vN[h][i]; }
        if constexpr (ALIGN_EPI) { if (wr == 1) PG8_BAR; }
    }
    PG8_WAIT_V(0);
    if constexpr (!ALIGN_EPI) { if (wr == 0) PG8_BAR; }
    PG8_BAR;
#undef PG8_SA
#undef PG8_SB
#undef PG8_STAGE
#undef PG8_LDA
#undef PG8_LDB
#undef PG8_MMA
#undef PG8_WAIT_V
#undef PG8_WAIT_L
#undef PG8_BAR
#undef PG8_SCHED
#undef PG8_AOFFS
#undef PG8_STA
}

struct EpiProj {
    static constexpr bool PERM = true;
    bf16_t* O; unsigned* KM;
    __device__ __forceinline__ void operator()(const f32x4 (&acc)[2][2][4][2], const Unit& u, int wr, int wc, int fr, int fq) const {
        const int row0 = u.pm * BM + wr * 64 + fr, col0 = u.pn * BM + wc * 32 + 8 * fq;
        const int mode = (u.pn < 4) ? 1 : (u.pn < 16 ? 0 : 2);
#pragma unroll
        for (int ai = 0; ai < 2; ++ai)
#pragma unroll
            for (int m = 0; m < 4; ++m) { bf16_t* rowp = O + (size_t)(row0 + ai * HALF + m * 16) * INW + col0;
#pragma unroll
                for (int bj = 0; bj < 2; ++bj) { f32x4 v0 = acc[ai][bj][m][0], v1 = acc[ai][bj][m][1];
                    if (mode == 1) {
#pragma unroll
                        for (int c = 0; c < 4; ++c) { v0[c] = gelu_tanh(v0[c]); v1[c] = gelu_tanh(v1[c]); }
                    } else if (mode == 2) {
#pragma unroll
                        for (int c = 0; c < 4; ++c) { v0[c] = sigmoidf_(v0[c]); v1[c] = sigmoidf_(v1[c]); }
                    }
                    u32x4 w; w.x = pk2(v0[0], v0[1]); w.y = pk2(v0[2], v0[3]); w.z = pk2(v1[0], v1[1]); w.w = pk2(v1[2], v1[3]);
                    *(u32x4*)(rowp + bj * HALF) = w; } }
        if (u.pn == 6 || u.pn == 7) {
            float mx[2] = {0.f, 0.f};
#pragma unroll
            for (int ai = 0; ai < 2; ++ai)
#pragma unroll
                for (int m = 0; m < 4; ++m)
#pragma unroll
                    for (int bj = 0; bj < 2; ++bj) { const f32x4 v0 = acc[ai][bj][m][0], v1 = acc[ai][bj][m][1];
                        float ss = (v0[0] * v0[0] + v0[1] * v0[1]) + (v0[2] * v0[2] + v0[3] * v0[3]) + (v1[0] * v1[0] + v1[1] * v1[1]) + (v1[2] * v1[2] + v1[3] * v1[3]);
                        ss += __builtin_bit_cast(float, __builtin_amdgcn_ds_swizzle(__builtin_bit_cast(int, ss), 0x401F));
                        { auto rr = __builtin_amdgcn_permlane32_swap(__float_as_uint(ss), __float_as_uint(ss), false, false); ss = __uint_as_float(rr[0]) + __uint_as_float(rr[1]); }
                        mx[bj] = fmaxf(mx[bj], ss); }
#pragma unroll
            for (int bj = 0; bj < 2; ++bj) { float v = mx[bj];
                v = fmaxf(v, dpp_f<0xB1>(v)); v = fmaxf(v, dpp_f<0x4E>(v)); v = fmaxf(v, dpp_f<0x141>(v)); v = fmaxf(v, dpp_f<0x140>(v));
                if (fr == 0 && fq == 0) __hip_atomic_fetch_max(KM + (u.pm >> 4) * 16 + (4 * (u.pn - 6) + 2 * bj + (wc >> 1)) * 2 + (wc & 1), __float_as_uint(v), __ATOMIC_RELAXED, __HIP_MEMORY_SCOPE_AGENT); }
        }
    }
};
template <bool FIRST> struct EpiGate {
    static constexpr bool PERM = true;
    bf16_t* P; const bf16_t* Gt;
    __device__ __forceinline__ void operator()(const f32x4 (&acc)[2][2][4][2], const Unit& u, int wr, int wc, int fr, int fq) const {
        const int row0 = u.pm * BM + wr * 64 + fr, col0 = u.pn * BM + wc * 32 + 8 * fq;
#pragma unroll
        for (int ai = 0; ai < 2; ++ai)
#pragma unroll
            for (int m = 0; m < 4; ++m) { const int row = row0 + ai * HALF + m * 16; asm volatile("" ::: "memory");
#pragma unroll
                for (int bj = 0; bj < 2; ++bj) {
                    const u32x4 g = *(const u32x4*)(Gt + (size_t)row * INW + col0 + bj * HALF);
                    bf16_t* pp = P + (size_t)row * DM + col0 + bj * HALF;
                    const f32x4 a0 = acc[ai][bj][m][0], a1 = acc[ai][bj][m][1];
                    float o[8];
                    o[0] = bf_lo(g.x) * a0[0]; o[1] = bf_hi(g.x) * a0[1]; o[2] = bf_lo(g.y) * a0[2]; o[3] = bf_hi(g.y) * a0[3];
                    o[4] = bf_lo(g.z) * a1[0]; o[5] = bf_hi(g.z) * a1[1]; o[6] = bf_lo(g.w) * a1[2]; o[7] = bf_hi(g.w) * a1[3];
                    if (!FIRST) { const u32x4 p = *(const u32x4*)pp;
                        o[0] += bf_lo(p.x); o[1] += bf_hi(p.x); o[2] += bf_lo(p.y); o[3] += bf_hi(p.y); o[4] += bf_lo(p.z); o[5] += bf_hi(p.z); o[6] += bf_lo(p.w); o[7] += bf_hi(p.w); }
                    u32x4 w; w.x = pk2(o[0], o[1]); w.y = pk2(o[2], o[3]); w.z = pk2(o[4], o[5]); w.w = pk2(o[6], o[7]);
                    *(u32x4*)pp = w; } }
    }
};
struct EpiRes {
    static constexpr bool PERM = true;
    float* X; float* XO;
    __device__ __forceinline__ void operator()(const f32x4 (&acc)[2][2][4][2], const Unit& u, int wr, int wc, int fr, int fq) const {
        const int row0 = u.pm * BM + wr * 64 + fr, col0 = u.pn * BM + wc * 32 + 8 * fq;
#pragma unroll
        for (int ai = 0; ai < 2; ++ai)
#pragma unroll
            for (int m = 0; m < 4; ++m) { const size_t ro = (size_t)(row0 + ai * HALF + m * 16) * DM + col0; asm volatile("" ::: "memory");
#pragma unroll
                for (int bj = 0; bj < 2; ++bj) { const f32x4* p = (const f32x4*)(X + ro + bj * HALF); f32x4* po = (f32x4*)(XO + ro + bj * HALF);
                    const f32x4 x0 = p[0], x1 = p[1]; po[0] = x0 + acc[ai][bj][m][0]; po[1] = x1 + acc[ai][bj][m][1]; } }
    }
};
struct EpiMoe1 {
    static constexpr bool PERM = true;
    bf16_t* H; const float* WL;
    __device__ __forceinline__ void operator()(const f32x4 (&acc)[2][2][4][2], const Unit& u, int wr, int wc, int fr, int fq) const {
        const int r0 = wr * 64 + fr, col0 = u.pn * HALF + wc * 32 + 8 * fq;
#pragma unroll
        for (int ai = 0; ai < 2; ++ai)
#pragma unroll
            for (int m = 0; m < 4; ++m) { const int r = r0 + ai * HALF + m * 16; const int li = u.base + r;
                const float wt = (li < u.n) ? WL[(size_t)u.e * LISTCAP + li] : 0.f;
                const f32x4 a0 = acc[ai][0][m][0], a1 = acc[ai][0][m][1], b0 = acc[ai][1][m][0], b1 = acc[ai][1][m][1];
                float o[8];
#pragma unroll
                for (int c = 0; c < 4; ++c) { o[c] = a0[c] * sigmoidf_(a0[c]) * b0[c] * wt; o[4 + c] = a1[c] * sigmoidf_(a1[c]) * b1[c] * wt; }
                u32x4 w; w.x = pk2(o[0], o[1]); w.y = pk2(o[2], o[3]); w.z = pk2(o[4], o[5]); w.w = pk2(o[6], o[7]);
                *(u32x4*)(H + (size_t)(u.pm * BM + r) * DFF + col0) = w; }
    }
};
struct EpiMoe2 {
    static constexpr bool PERM = true;
    bf16_t* YS; const unsigned* LIST;
    __device__ __forceinline__ void operator()(const f32x4 (&acc)[2][2][4][2], const Unit& u, int wr, int wc, int fr, int fq) const {
        const int r0 = wr * 64 + fr, col0 = u.pn * BM + wc * 32 + 8 * fq;
#pragma unroll
        for (int ai = 0; ai < 2; ++ai)
#pragma unroll
            for (int m = 0; m < 4; ++m) { const int r = r0 + ai * HALF + m * 16; const int li = u.base + r; asm volatile("" ::: "memory");
                if (li < u.n) { const unsigned ent = LIST[(size_t)u.e * LISTCAP + li]; const unsigned tok = ent & 0x7fffffffu, slot = ent >> 31;
                    bf16_t* rowp = YS + ((size_t)slot * T + tok) * DM + col0;
#pragma unroll
                    for (int bj = 0; bj < 2; ++bj) { const f32x4 v0 = acc[ai][bj][m][0], v1 = acc[ai][bj][m][1];
                        u32x4 w; w.x = pk2(v0[0], v0[1]); w.y = pk2(v0[2], v0[3]); w.z = pk2(v1[0], v1[1]); w.w = pk2(v1[2], v1[3]);
                        *(u32x4*)(rowp + bj * HALF) = w; } } }
    }
};
}

template <bool GATHER> struct MoeOrder {
    int G, c, npn; const LAS int* PFX; const LAS int* CNT; const bf16_t* Bt; size_t estride; int K; const unsigned* LIST;
    __device__ __forceinline__ bool next(int i, pg8::Unit& u) const {
        const int L = i * G + c; const int rt = L / npn; if (rt >= PFX[16]) return false;
        const int e = PFX[32 + rt];
        u.pm = rt; u.pn = L % npn; u.e = e; u.base = (rt - PFX[e]) * 256; u.n = CNT[e]; return true;
    }
    __device__ __forceinline__ const char* b_base(const pg8::Unit& u) const { return (const char*)Bt + (size_t)u.e * estride + (size_t)u.pn * (size_t)(256 * K * 2); }
    __device__ __forceinline__ unsigned a_row(const pg8::Unit& u, int r) const {
        if (GATHER) { const int li = u.base + r; return (li < u.n) ? (LIST[(size_t)u.e * LISTCAP + li] & 0x7fffffffu) : 0u; }
        return (unsigned)(u.pm * 256 + r);
    }
};

#define XB_TMO      128
#define XB_XCNT(j)  (256  + 64 * (j))
#define XB_XSUB(j)  (1280 + 64 * (j))
#define XB_XGEN(j)  (2304 + 64 * (j))
#define XB_TOP      3328
#define XB_TOPGEN   3392
#define XCD_BAR_WORDS 3456
#define XB_SPIN_CAP (1u << 18)
__device__ __forceinline__ unsigned xb_ld(unsigned* p)              { return __hip_atomic_load(p, __ATOMIC_RELAXED, __HIP_MEMORY_SCOPE_AGENT); }
__device__ __forceinline__ unsigned xb_add(unsigned* p, unsigned v) { return __hip_atomic_fetch_add(p, v, __ATOMIC_RELAXED, __HIP_MEMORY_SCOPE_AGENT); }
__device__ __forceinline__ unsigned xb_xcc_id() { return (unsigned)__builtin_amdgcn_s_getreg((3 << 11) | 20) & 0xFu; }
#define XB_SPIN(cond, bar) do { unsigned _sp = 0; while (cond) { __builtin_amdgcn_s_sleep(1); \
    if ((++_sp & 255u) == 0u) { if (xb_ld(&(bar)[XB_TMO])) break; if (_sp > XB_SPIN_CAP) { atomicAdd(&(bar)[XB_TMO], 1u); break; } } } } while (0)
struct XcdBarrier { unsigned* bar; unsigned x; volatile LAS unsigned* st; };
__device__ __forceinline__ XcdBarrier xcd_barrier_post(unsigned* bar, volatile LAS unsigned* st) {
    XcdBarrier b; b.bar = bar; b.x = xb_xcc_id(); b.st = st;
    if (threadIdx.x == 0) (void)xb_add(&bar[XB_XCNT(b.x)], 1u);
    return b;
}
__device__ __forceinline__ void xcd_barrier_complete(unsigned* bar, unsigned x, unsigned& nloc, unsigned& nx) {
    const unsigned G = gridDim.x * gridDim.y * gridDim.z;
    unsigned sum, cnt, mine, sp = 0u;
    for (;;) {
        sum = 0u; cnt = 0u; mine = 0u;
#pragma unroll
        for (unsigned j = 0; j < 16; ++j) { const unsigned c = xb_ld(&bar[XB_XCNT(j)]); sum += c; cnt += (c > 0u) ? 1u : 0u; mine = (j == x) ? c : mine; }
        if (sum == G) break;
        __builtin_amdgcn_s_sleep(1);
        if ((++sp & 255u) == 0u) { if (xb_ld(&bar[XB_TMO])) break; if (sp > XB_SPIN_CAP) { atomicAdd(&bar[XB_TMO], 1u); break; } }
    }
    nloc = mine > 0u ? mine : 1u; nx = cnt > 0u ? cnt : 1u;
}
__device__ __forceinline__ void xcd_barrier(const XcdBarrier& b) {
    asm volatile("s_waitcnt vmcnt(0)" ::: "memory");
    __syncthreads();
    if (threadIdx.x == 0) {
        unsigned* bar = b.bar;
        __builtin_amdgcn_s_waitcnt(0);
        unsigned nloc = b.st[0], nx = b.st[1];
        if (nloc == 0u) { xcd_barrier_complete(bar, b.x, nloc, nx); b.st[0] = nloc; b.st[1] = nx; }
        const unsigned old = xb_add(&bar[XB_XSUB(b.x)], 1u);
        const unsigned gen = old / nloc;
        if (old + 1u == (gen + 1u) * nloc) {
            __builtin_amdgcn_fence(__ATOMIC_RELEASE, "agent");
            asm volatile("s_waitcnt vmcnt(0)" ::: "memory");
            const unsigned og = xb_add(&bar[XB_TOP], 1u);
            const unsigned tg = og / nx;
            if (og + 1u == (tg + 1u) * nx) xb_add(&bar[XB_TOPGEN], 1u);
            else XB_SPIN(xb_ld(&bar[XB_TOPGEN]) == tg, bar);
            __builtin_amdgcn_fence(__ATOMIC_ACQUIRE, "agent");
            xb_add(&bar[XB_XGEN(b.x)], 1u);
            asm volatile("s_waitcnt vmcnt(0)" ::: "memory");
        } else {
            XB_SPIN(xb_ld(&bar[XB_XGEN(b.x)]) == gen, bar);
            __builtin_amdgcn_fence(__ATOMIC_ACQUIRE, "agent");
            asm volatile("s_waitcnt vmcnt(0)" ::: "memory");
        }
    }
    __syncthreads();
}

struct Args { const float* in[19]; float* out; unsigned char* ws; int ph_lo, ph_hi; float lam_init[4]; };
typedef const __attribute__((address_space(4))) Args* ArgsP;
typedef const GAS float* gfp;
#define GIN(i) ((gfp)a->in[i])
enum { I_X = 0, I_GMIX, I_WIN, I_WS, I_BS, I_GV, I_LAM, I_SUBLN, I_UPA, I_UPB, I_UPC, I_WOUT, I_GFFN, I_RW, I_RB, I_W1, I_W3, I_W2, I_FG };

struct Frame {
    LAS unsigned char* lds;
    gu32* ctl;
    int tid, lane, wave, vcu, G;
    unsigned char* ws;
};

__device__ __forceinline__ Frame phase_frame(const Frame& F0) {
    Frame F = F0; int ln = (int)__builtin_amdgcn_mbcnt_hi(~0u, __builtin_amdgcn_mbcnt_lo(~0u, 0u)); asm volatile("" : "+v"(ln)); F.lane = ln; F.tid = F0.wave * 64 + ln;
    size_t z = 0; asm volatile("" : "+s"(z)); unsigned char* w = F0.ws + z; F.ws = w; F.ctl = (gu32*)(w + WS_CTL);
    int v = F0.vcu, g = F0.G; asm volatile("" : "+s"(v), "+s"(g)); F.vcu = v; F.G = g;
    return F;
}
__device__ __forceinline__ void transpose_item(gfp W, int K, int N, bf16_t* WT, int rowT0, int k0, int n0, LAS float* scr, int lane) {
#pragma unroll 8
    for (int i = 0; i < 32; ++i) { const int kk = 2 * i + (lane >> 5); scr[kk * 33 + (lane & 31)] = W[(size_t)(k0 + kk) * N + n0 + (lane & 31)]; }
    asm volatile("s_waitcnt lgkmcnt(0)" ::: "memory");
    const int c = lane & 7;
#pragma unroll
    for (int j = 0; j < 4; ++j) { const int n = (lane >> 3) + 8 * j; const LAS float* s = scr + (8 * c) * 33 + n;
        u32x4 o; o.x = pk2(s[0 * 33], s[1 * 33]); o.y = pk2(s[2 * 33], s[3 * 33]); o.z = pk2(s[4 * 33], s[5 * 33]); o.w = pk2(s[6 * 33], s[7 * 33]);
        *(GAS u32x4*)(WT + (size_t)(rowT0 + n) * K + k0 + 8 * c) = o; }
    asm volatile("s_waitcnt lgkmcnt(0)" ::: "memory");
}
__device__ __forceinline__ void tr_matrix_item(gfp W, int K, int N, bf16_t* WT, int it, LAS float* scr, int lane) {
    const int nblk = N / 32, kb = it / nblk, nb = it % nblk;
    transpose_item(W, K, N, WT, 32 * nb, 64 * kb, 32 * nb, scr, lane);
}
__device__ __forceinline__ void convert_weights(const Frame& F_, ArgsP a, int l) {
    const Frame F = phase_frame(F_);
    LAS float* scr = (LAS float*)(F.lds + F.wave * 16384);
    const int gw = F.vcu * NWAVES + F.wave, NGW = F.G * NWAVES;
    bf16_t* Wb = (bf16_t*)(F.ws + WS_W);
    constexpr int I_IN = (DM / 64) * (INW / 32);
    constexpr int I_UP1 = (512 / 64) * (DM / 32);
    constexpr int I_OUT = (DM / 64) * (DM / 32);
    constexpr int I_E1 = (DM / 64) * (DFF / 32);
    constexpr int I_E2 = (DFF / 64) * (DM / 32);
    constexpr int I_EX = 2 * I_E1 + I_E2;
    constexpr int NITEMS = I_IN + 3 * I_UP1 + I_OUT + NE * I_EX;
    for (int it = gw; it < NITEMS; it += NGW) {
        int r = it;
        if (r < I_IN) { tr_matrix_item(GIN(I_WIN) + (size_t)l * DM * INW, DM, INW, Wb + W_IN / 2, r, scr, F.lane); continue; } r -= I_IN;
        if (r < 3 * I_UP1) { const int s = r / I_UP1; tr_matrix_item(GIN(I_UPA + s) + (size_t)l * 512 * DM, 512, DM, Wb + W_UP / 2 + (size_t)s * DM * 512, r % I_UP1, scr, F.lane); continue; } r -= 3 * I_UP1;
        if (r < I_OUT) { tr_matrix_item(GIN(I_WOUT) + (size_t)l * DM * DM, DM, DM, Wb + W_OUT / 2, r, scr, F.lane); continue; } r -= I_OUT;
        const int e = r / I_EX; r %= I_EX;
        if (r < 2 * I_E1) { const int which = r / I_E1; r %= I_E1;
            gfp W = GIN(which ? I_W3 : I_W1) + ((size_t)l * NE + e) * DM * DFF;
            const int nblk = DFF / 32, kb = r / nblk, nb = r % nblk, n0 = 32 * nb;
            transpose_item(W, DM, DFF, Wb + W_13 / 2 + (size_t)e * DM * DM, 256 * (n0 / 128) + 128 * which + (n0 % 128), 64 * kb, n0, scr, F.lane);
        } else { r -= 2 * I_E1;
            tr_matrix_item(GIN(I_W2) + ((size_t)l * NE + e) * DFF * DM, DFF, DM, Wb + W_2 / 2 + (size_t)e * DM * DFF, r, scr, F.lane); }
    }
}

template <int MODE  >
__device__ __forceinline__ void norm_rows(const Frame& F_, ArgsP a, int l) {
    const Frame F = phase_frame(F_);
    gfp gain = (MODE == 2) ? GIN(I_FG) : GIN(I_GMIX) + (size_t)l * DM;
    float* X = (float*)(F.ws + WS_X); bf16_t* XN = (bf16_t*)(F.ws + WS_ACT); const bf16_t* YS = (const bf16_t*)(F.ws + WS_YS);
    f32x4 g[4];
#pragma unroll
    for (int j = 0; j < 4; ++j) g[j] = *(const GAS f32x4*)(gain + 256 * j + 4 * F.lane);
    const int gw = F.vcu * NWAVES + F.wave, NGW = F.G * NWAVES;
    for (int m = gw; m < T; m += NGW) {
        gfp src = (MODE == 0) ? GIN(I_X) + (size_t)m * DM : (gfp)X + (size_t)m * DM;
        f32x4 v[4]; float ss = 0.f;
#pragma unroll
        for (int j = 0; j < 4; ++j) { v[j] = *(const GAS f32x4*)(src + 256 * j + 4 * F.lane);
            if (MODE != 0) {
                const u32x2 y0 = *(const u32x2*)(YS + (size_t)m * DM + 256 * j + 4 * F.lane), y1 = *(const u32x2*)(YS + ((size_t)T + m) * DM + 256 * j + 4 * F.lane);
                v[j][0] += bf_lo(y0.x) + bf_lo(y1.x); v[j][1] += bf_hi(y0.x) + bf_hi(y1.x); v[j][2] += bf_lo(y0.y) + bf_lo(y1.y); v[j][3] += bf_hi(y0.y) + bf_hi(y1.y); }
            ss += (v[j][0] * v[j][0] + v[j][1] * v[j][1]) + (v[j][2] * v[j][2] + v[j][3] * v[j][3]); }
        const float rstd = 1.0f / sqrtf(wave_sum(ss) * (1.0f / DM) + EPS);
#pragma unroll
        for (int j = 0; j < 4; ++j) {
            const f32x4 o = v[j] * rstd * g[j];
            if (MODE == 2) *(GAS f32x4*)((GAS float*)a->out + (size_t)m * DM + 256 * j + 4 * F.lane) = o;
            else { if (MODE != 3) *(f32x4*)(X + (size_t)m * DM + 256 * j + 4 * F.lane) = v[j];
                   u32x2 w; w.x = pk2(o[0], o[1]); w.y = pk2(o[2], o[3]); *(u32x2*)(XN + (size_t)m * DM + 256 * j + 4 * F.lane) = w; } }
    }
}

template <bool DRY> __device__ __forceinline__ void t2_phase(const Frame& F_, ArgsP a, int l) {
    const Frame F = phase_frame(F_);
    LAS float* RW = (LAS float*)(F.lds);
    LAS float* lsc = (LAS float*)(F.lds + 65536 + F.wave * 256);
    LAS int* lcnt = (LAS int*)(F.lds + 69632);
    LAS int* gbase = lcnt + 16;
    LAS int* tE = lcnt + 32;
    LAS int* tP = tE + 128;
    LAS float* tW = (LAS float*)(tP + 128);
    gfp rw = GIN(I_RW); gfp rb = GIN(I_RB); gfp gain = GIN(I_GFFN) + (size_t)l * DM;
    const float* X = (const float*)(F.ws + WS_X); bf16_t* XN = (bf16_t*)(F.ws + WS_ACT);
    unsigned* LIST = (unsigned*)(F.ws + WS_LIST); float* WL = (float*)(F.ws + WS_WL);
    for (int i = F.tid; i < DM * NE / 4; i += NTHREADS) { const f32x4 w = ((const GAS f32x4*)rw)[i]; const int k = i >> 2, e0 = (i & 3) * 4;
        RW[(e0 + 0) * DM + k] = w[0]; RW[(e0 + 1) * DM + k] = w[1]; RW[(e0 + 2) * DM + k] = w[2]; RW[(e0 + 3) * DM + k] = w[3]; }
    if (F.tid < 32) lcnt[F.tid] = 0;
    __syncthreads();
    f32x4 g[4];
#pragma unroll
    for (int j = 0; j < 4; ++j) g[j] = *(const GAS f32x4*)(gain + 256 * j + 4 * F.lane);
    const int rows_per_wg = T / F.G;
    const int row0 = F.vcu * rows_per_wg;
    constexpr int RB = 2;
#pragma unroll 1
    for (int bt = 0; bt < rows_per_wg / (NWAVES * RB); ++bt) {
        const int lr0 = (bt * NWAVES + F.wave) * RB;
        float hn[RB][16];
#pragma unroll
        for (int r = 0; r < RB; ++r) { const int m = row0 + lr0 + r; f32x4 v[4]; float ss = 0.f;
#pragma unroll
            for (int j = 0; j < 4; ++j) { v[j] = *(const f32x4*)(X + (size_t)m * DM + 256 * j + 4 * F.lane); ss += (v[j][0] * v[j][0] + v[j][1] * v[j][1]) + (v[j][2] * v[j][2] + v[j][3] * v[j][3]); }
            const float rstd = 1.0f / sqrtf(wave_sum(ss) * (1.0f / DM) + EPS);
#pragma unroll
            for (int j = 0; j < 4; ++j) { const f32x4 o = v[j] * rstd * g[j];
                hn[r][4 * j + 0] = o[0]; hn[r][4 * j + 1] = o[1]; hn[r][4 * j + 2] = o[2]; hn[r][4 * j + 3] = o[3];
                u32x2 w; w.x = pk2(o[0], o[1]); w.y = pk2(o[2], o[3]); *(u32x2*)(XN + (size_t)m * DM + 256 * j + 4 * F.lane) = w; } }
        float acc[RB][16];
#pragma unroll
        for (int r = 0; r < RB; ++r)
#pragma unroll
            for (int e = 0; e < 16; ++e) acc[r][e] = 0.f;
#pragma unroll
        for (int j = 0; j < 4; ++j)
#pragma unroll
            for (int eg = 0; eg < 4; ++eg) { asm volatile("" ::: "memory");
                f32x4 w4[4];
#pragma unroll
                for (int q = 0; q < 4; ++q) w4[q] = *(const LAS f32x4*)(RW + (4 * eg + q) * DM + 256 * j + 4 * F.lane);
#pragma unroll
                for (int r = 0; r < RB; ++r)
#pragma unroll
                    for (int q = 0; q < 4; ++q) acc[r][4 * eg + q] += (hn[r][4 * j + 0] * w4[q][0] + hn[r][4 * j + 1] * w4[q][1]) + (hn[r][4 * j + 2] * w4[q][2] + hn[r][4 * j + 3] * w4[q][3]);
#pragma unroll
                for (int r = 0; r < RB; ++r) asm volatile("" : "+v"(acc[r][0]), "+v"(acc[r][1]), "+v"(acc[r][2]), "+v"(acc[r][3]), "+v"(acc[r][4]), "+v"(acc[r][5]), "+v"(acc[r][6]), "+v"(acc[r][7]),
                    "+v"(acc[r][8]), "+v"(acc[r][9]), "+v"(acc[r][10]), "+v"(acc[r][11]), "+v"(acc[r][12]), "+v"(acc[r][13]), "+v"(acc[r][14]), "+v"(acc[r][15])); }
#pragma unroll
        for (int r = 0; r < RB; ++r)
#pragma unroll
            for (int e = 0; e < 16; ++e) { const float s = wave_sum(acc[r][e]); if (F.lane == 0) lsc[r * 16 + e] = s; }
        asm volatile("s_waitcnt lgkmcnt(0)" ::: "memory");
        if (F.lane < RB) {
            const int r = F.lane; LAS float* lg = lsc + r * 16;
            float best_gs = -1e30f; int best = 0;
#pragma unroll
            for (int gI = 0; gI < 4; ++gI) { float m1 = -1e30f, m2 = -1e30f;
#pragma unroll
                for (int i = 0; i < 4; ++i) { const float af = 1.0f / (1.0f + expf(-lg[4 * gI + i])); const float s = af + rb[4 * gI + i];
                    if (s > m1) { m2 = m1; m1 = s; } else if (s > m2) m2 = s; }
                const float gs = m1 + m2; if (gs > best_gs) { best_gs = gs; best = gI; } }
            float s1 = -1e30f, s2 = -1e30f; int i1 = 0, i2 = 0; float a1 = 0.f, a2 = 0.f;
#pragma unroll
            for (int i = 0; i < 4; ++i) { const float af = 1.0f / (1.0f + expf(-lg[4 * best + i])); const float s = af + rb[4 * best + i];
                if (s > s1) { s2 = s1; i2 = i1; a2 = a1; s1 = s; i1 = i; a1 = af; } else if (s > s2) { s2 = s; i2 = i; a2 = af; } }
            const int e0 = 4 * best + i1, e1 = 4 * best + i2; const float inv = 1.0f / (a1 + a2);
            const int lr = lr0 + r;
            tE[lr] = e0; tE[64 + lr] = e1; tW[lr] = a1 * inv; tW[64 + lr] = a2 * inv;
            tP[lr] = atomicAdd((int*)&lcnt[e0], 1); tP[64 + lr] = atomicAdd((int*)&lcnt[e1], 1);
        }
    }
    __syncthreads();
    if (DRY) { if (F.tid < 16) gbase[F.tid] = 0; } else if (F.tid < 16) gbase[F.tid] = (int)__hip_atomic_fetch_add((unsigned*)(F.ctl + CW_CNT + 64 * l + F.tid), (unsigned)lcnt[F.tid], __ATOMIC_RELAXED, __HIP_MEMORY_SCOPE_AGENT);
    __syncthreads();
    if (!DRY && F.tid < 2 * rows_per_wg) { const int slot = F.tid / rows_per_wg, lr = F.tid % rows_per_wg; const int e = tE[slot * 64 + lr]; const int pos = gbase[e] + tP[slot * 64 + lr];
        LIST[(size_t)e * LISTCAP + pos] = (unsigned)(row0 + lr) | ((unsigned)slot << 31); WL[(size_t)e * LISTCAP + pos] = tW[slot * 64 + lr]; }
    __syncthreads();
}

__device__ __forceinline__ void gmlp_unit(const Frame& F_, ArgsP a, int l, int unit) {
    const Frame F = phase_frame(F_);
    constexpr int VST = 320;
    const int c = unit >> 2, g = unit & 3; const int t0 = c * 128;
    const bf16_t* PROJ = (const bf16_t*)(F.ws + WS_PROJ); bf16_t* YA = (bf16_t*)(F.ws + WS_Y);
    LAS unsigned char* gv = F.lds; LAS float* rs = (LAS float*)(F.lds + 40960);
    {
        const int row = F.tid >> 2, qt = F.tid & 3; const bf16_t* p = PROJ + (size_t)(t0 + row) * INW + C_VA + qt * 128; float ss = 0.f;
#pragma unroll
        for (int i = 0; i < 16; ++i) { const u32x4 w = *(const u32x4*)(p + 8 * i);
            ss += bf_lo(w.x) * bf_lo(w.x) + bf_hi(w.x) * bf_hi(w.x) + bf_lo(w.y) * bf_lo(w.y) + bf_hi(w.y) * bf_hi(w.y) + bf_lo(w.z) * bf_lo(w.z) + bf_hi(w.z) * bf_hi(w.z) + bf_lo(w.w) * bf_lo(w.w) + bf_hi(w.w) * bf_hi(w.w); }
        ss += xor1_f(ss); ss += xor2_f(ss);
        if (qt == 0) rs[row] = 1.0f / sqrtf(ss * (1.0f / 512.0f) + EPS);
#pragma unroll
        for (int j = 0; j < 4; ++j) { const int id = F.tid + 512 * j, r = id >> 4, ch = id & 15;
            *(LAS u32x4*)(gv + r * VST + ch * 16) = *(const u32x4*)(PROJ + (size_t)(t0 + r) * INW + C_VA + g * 128 + ch * 8); }
    }
    __syncthreads();
    const int wt = F.wave >> 1, dh = F.wave & 1, r32 = F.lane & 31, hh = F.lane >> 5;
    const int q4 = (F.lane & 15) >> 2, p4 = F.lane & 3, blk = (F.lane >> 4) & 1;
    const int tl = 32 * wt + r32;
    gfp wrow = GIN(I_WS) + (((size_t)l * 4 + g) * 128 + tl) * 128;
    f32x16 acc[2]; acc[0] = f32x16{}; acc[1] = f32x16{};
    f32x4 wv4[8][2];
#pragma unroll
    for (int ks = 0; ks < 8; ++ks) if (16 * ks <= 32 * wt + 31) { wv4[ks][0] = *(const GAS f32x4*)(wrow + 16 * ks + 8 * hh); wv4[ks][1] = *(const GAS f32x4*)(wrow + 16 * ks + 8 * hh + 4); }
#pragma unroll
    for (int ks = 0; ks < 8; ++ks) {
        if (16 * ks <= 32 * wt + 31) {
        const int s0 = 16 * ks + 8 * hh;
        const f32x4 w0 = wv4[ks][0], w1 = wv4[ks][1];
        const f32x4 r0 = *(const LAS f32x4*)(rs + s0), r1 = *(const LAS f32x4*)(rs + s0 + 4);
        float wv[8];
#pragma unroll
        for (int j = 0; j < 4; ++j) { wv[j] = (s0 + j <= tl) ? w0[j] * r0[j] : 0.f; wv[4 + j] = (s0 + 4 + j <= tl) ? w1[j] * r1[j] : 0.f; }
        u32x4 wp; wp.x = pk2(wv[0], wv[1]); wp.y = pk2(wv[2], wv[3]); wp.z = pk2(wv[4], wv[5]); wp.w = pk2(wv[6], wv[7]);
        const bf16x8 wfr = __builtin_bit_cast(bf16x8, wp);
#pragma unroll
        for (int di = 0; di < 2; ++di) { const int dt = 2 * dh + di;
            const s16x4 lo = vtr(gv + (16 * ks + 8 * hh + q4) * VST + 64 * dt + 32 * blk + 8 * p4);
            const s16x4 hi = vtr(gv + (16 * ks + 8 * hh + 4 + q4) * VST + 64 * dt + 32 * blk + 8 * p4);
            const bf16x8 gfr = __builtin_shufflevector(lo, hi, 0, 1, 2, 3, 4, 5, 6, 7);
            acc[di] = MFMA32(gfr, wfr, acc[di]); }
        }
    }
    const float bias = GIN(I_BS)[((size_t)l * 4 + g) * 128 + tl];
    gfp gvg = GIN(I_GV) + (size_t)l * 512 + g * 128;
    const bf16_t* urow = PROJ + (size_t)(t0 + tl) * INW + C_UA + g * 128; bf16_t* yrow = YA + (size_t)(t0 + tl) * 512 + g * 128;
#pragma unroll
    for (int di = 0; di < 2; ++di)
#pragma unroll
        for (int G4 = 0; G4 < 4; ++G4) { const int d = 32 * (2 * dh + di) + 8 * G4 + 4 * hh;
            const f32x4 gg = *(const GAS f32x4*)(gvg + d); const u32x2 uu = *(const u32x2*)(urow + d);
            const float o0 = bf_lo(uu.x) * (acc[di][4 * G4 + 0] * gg[0] + bias), o1 = bf_hi(uu.x) * (acc[di][4 * G4 + 1] * gg[1] + bias);
            const float o2 = bf_lo(uu.y) * (acc[di][4 * G4 + 2] * gg[2] + bias), o3 = bf_hi(uu.y) * (acc[di][4 * G4 + 3] * gg[3] + bias);
            u32x2 w; w.x = pk2(o0, o1); w.y = pk2(o2, o3); *(u32x2*)(yrow + d) = w; }
    __syncthreads();
}

__device__ __forceinline__ void glds16(const void* gsrc, unsigned lds_dst) { unsigned keep;
    asm volatile("s_mov_b32 %0, m0\n\ts_mov_b32 m0, %2\n\ts_nop 0\n\tglobal_load_lds_dwordx4 %1, off\n\ts_mov_b32 m0, %0" : "=&s"(keep) : "v"(gsrc), "s"(lds_dst) : "memory"); }
#define AT_WAIT_BAR(N) asm volatile("s_waitcnt vmcnt(" #N ") lgkmcnt(0)\n\ts_barrier" ::: "memory")

__device__ __forceinline__ void sb_unit(const Frame& F_, int unit) {
    const Frame F = phase_frame(F_);
    constexpr int SLOT = 16384, NS = 4;
    const int b = unit >> 7, h = (unit >> 4) & 7, qb = unit & 15;
    const bf16_t* PROJ = (const bf16_t*)(F.ws + WS_PROJ); bf16_t* YC = (bf16_t*)(F.ws + WS_Y) + (size_t)2 * T * 512;
    const size_t rowbase = (size_t)b * SEQ; const int q0 = qb * 256;
    const int r32 = F.lane & 31, hh = F.lane >> 5, q4 = (F.lane & 15) >> 2, p4 = F.lane & 3, blk = (F.lane >> 4) & 1;
    const int qa = q0 + 32 * F.wave, qpos = qa + r32;
    bf16x8 qf[4];
#pragma unroll
    for (int ks = 0; ks < 4; ++ks) qf[ks] = *(const bf16x8*)(PROJ + (rowbase + qpos) * INW + C_QC + h * 64 + 16 * ks + 8 * hh);
    const int drow = F.wave * 8 + (F.lane >> 3), dpos = F.lane & 7;
    const bf16_t* ksrc = PROJ + (rowbase + drow) * INW + C_KC + h * 64 + (dpos ^ ((drow >> 1) & 7)) * 8;
    const bf16_t* vsrc = PROJ + (rowbase + drow) * INW + C_VC + h * 64 + ((((dpos >> 2) ^ ((drow >> 1) & 1)) << 2) | (dpos & 3)) * 8;
    const unsigned lds0 = (unsigned)(size_t)F.lds + (unsigned)F.wave * 1024u;
#define SB_DMA(kt, slot) do { const size_t o_ = (size_t)(kt) * 64 * INW; const unsigned d_ = (unsigned)__builtin_amdgcn_readfirstlane(lds0 + (unsigned)(slot) * SLOT); glds16(ksrc + o_, d_); glds16(vsrc + o_, d_ + 8192u); } while (0)
    f32x16 o[2]; o[0] = f32x16{}; o[1] = f32x16{};
    float carry = 0.f; bool done = false;
    const int kt_hi = (q0 + 255) >> 6;
    SB_DMA(kt_hi, 0); SB_DMA(kt_hi - 1, 1); SB_DMA(kt_hi - 2, 2);
    int slot = 0, nslot = 3;
    for (int kt = kt_hi; kt >= 0; --kt) {
        const int k0 = kt * 64;
        if (kt >= 2) AT_WAIT_BAR(4); else if (kt == 1) AT_WAIT_BAR(2); else AT_WAIT_BAR(0);
        if (kt != kt_hi) { volatile LAS unsigned* fl = (volatile LAS unsigned*)(F.lds + MISC_OFF + 512) + (((kt + 1) & 1) << 3);
            const unsigned any_left = (fl[0] | fl[1]) | (fl[2] | fl[3]) | (fl[4] | fl[5]) | (fl[6] | fl[7]);
            if (!any_left) break; }
        if (kt >= 3) SB_DMA(kt - 3, nslot);
        LAS unsigned char* Kb = F.lds + slot * SLOT; LAS unsigned char* Vb = Kb + 8192;
        if (!done && k0 < qa + 31) {
#pragma unroll
            for (int sub = 1; sub >= 0; --sub) {
                const int kb0 = k0 + 32 * sub;
                if (kb0 < qa + 31) {
                    f32x16 sacc = f32x16{};
                    const int R = 32 * sub + r32;
#pragma unroll
                    for (int ks = 0; ks < 4; ++ks) { const bf16x8 kfr = *(const LAS bf16x8*)(Kb + R * 128 + (((2 * ks + hh) ^ ((R >> 1) & 7)) << 4)); sacc = MFMA32(kfr, qf[ks], sacc); }
                    float lk[16], lb[16];
#pragma unroll
                    for (int r = 0; r < 16; ++r) { const float z2 = sacc[r] * (0.125f * LOG2E); const float sp2 = fmaxf(z2, 0.f) + flog2(1.0f + fexp2(-fabsf(z2)));
                        const bool valid = (kb0 + crow(r, hh)) < qpos; lk[r] = valid ? -sp2 : 0.f; lb[r] = valid ? (z2 - sp2) : -1e30f; }
                    float gs[4], og[4];
#pragma unroll
                    for (int G4 = 0; G4 < 4; ++G4) { gs[G4] = (lk[4 * G4] + lk[4 * G4 + 1]) + (lk[4 * G4 + 2] + lk[4 * G4 + 3]); og[G4] = other_half(gs[G4], hh); }
                    float hi_sum = 0.f;
                    float av[16];
#pragma unroll
                    for (int G4 = 3; G4 >= 0; --G4) {
                        float suf = carry + hi_sum + (hh == 0 ? og[G4] : 0.f);
#pragma unroll
                        for (int cI = 3; cI >= 0; --cI) { av[4 * G4 + cI] = fexp2(lb[4 * G4 + cI] + suf); suf += lk[4 * G4 + cI]; }
                        hi_sum += gs[G4] + og[G4];
                    }
                    carry += hi_sum;
#pragma unroll
                    for (int s = 0; s < 2; ++s) {
                        u32x4 pw; pw.x = pk2(av[8 * s + 0], av[8 * s + 1]); pw.y = pk2(av[8 * s + 2], av[8 * s + 3]); pw.z = pk2(av[8 * s + 4], av[8 * s + 5]); pw.w = pk2(av[8 * s + 6], av[8 * s + 7]);
                        const bf16x8 pa = __builtin_bit_cast(bf16x8, pw);
#pragma unroll
                        for (int dt = 0; dt < 2; ++dt) {
                            const int wofs = ((dt ^ ((q4 >> 1) & 1)) << 6) + 32 * blk + 8 * p4;
                            const s16x4 lo = vtr(Vb + (32 * sub + 16 * s + 4 * hh + q4) * 128 + wofs);
                            const s16x4 hi = vtr(Vb + (32 * sub + 16 * s + 8 + 4 * hh + q4) * 128 + wofs);
                            const bf16x8 vfr = __builtin_shufflevector(lo, hi, 0, 1, 2, 3, 4, 5, 6, 7);
                            o[dt] = MFMA32(vfr, pa, o[dt]); }
                    }
                }
            }
            if (__all(carry < -45.0f)) done = true;
        }
        if (kt == 0) done = true;
        { volatile LAS unsigned* fl = (volatile LAS unsigned*)(F.lds + MISC_OFF + 512) + ((kt & 1) << 3); if (F.lane == 0) fl[F.wave] = done ? 0u : 1u; }
        slot = (slot == NS - 1) ? 0 : slot + 1; nslot = (nslot == NS - 1) ? 0 : nslot + 1;
    }
#undef SB_DMA
    bf16_t* yrow = YC + (rowbase + qpos) * 512 + h * 64;
#pragma unroll
    for (int dt = 0; dt < 2; ++dt)
#pragma unroll
        for (int G4 = 0; G4 < 4; ++G4) { u32x2 w; w.x = pk2(o[dt][4 * G4], o[dt][4 * G4 + 1]); w.y = pk2(o[dt][4 * G4 + 2], o[dt][4 * G4 + 3]);
            *(u32x2*)(yrow + 32 * dt + 8 * G4 + 4 * hh) = w; }
    AT_WAIT_BAR(0);
}

__device__ __forceinline__ void da_unit(const Frame& F_, ArgsP a, int l, int b, int h, int qblk) {
    const Frame F = phase_frame(F_);
    constexpr int SLOT = 32768, NS = 4;
    const bf16_t* PROJ = (const bf16_t*)(F.ws + WS_PROJ); bf16_t* YB = (bf16_t*)(F.ws + WS_Y) + (size_t)T * 512;
    const size_t rowbase = (size_t)b * SEQ; const int q0 = qblk * 128;
    const int map = F.wave >> 2, wq = F.wave & 3;
    const int r32 = F.lane & 31, hh = F.lane >> 5, q4 = (F.lane & 15) >> 2, p4 = F.lane & 3, blk = (F.lane >> 4) & 1;
    const int qa = q0 + 32 * wq, qpos = qa + r32;
    const float slope = (h == 0) ? 0.25f : (h == 1) ? 0.0625f : (h == 2) ? 0.015625f : 0.00390625f;
    const float c1 = 0.125f * LOG2E, c2 = slope * LOG2E;
    bf16x8 qf[4];
#pragma unroll
    for (int ks = 0; ks < 4; ++ks) qf[ks] = *(const bf16x8*)(PROJ + (rowbase + qpos) * INW + C_QB + h * 128 + map * 64 + 16 * ks + 8 * hh);
    const int krow = F.wave * 8 + (F.lane >> 3), kpos = F.lane & 7;
    const bf16_t* ksrc = PROJ + (rowbase + krow) * INW + C_KB + h * 128 + (kpos ^ ((krow >> 1) & 7)) * 8;
    const int vrow = F.wave * 4 + (F.lane >> 4), vpos = F.lane & 15;
    const bf16_t* vsrc = PROJ + (rowbase + vrow) * INW + C_VB + h * 128 + ((((vpos >> 2) ^ (vrow & 3)) << 2) | (vpos & 3)) * 8;
    const unsigned lds0 = (unsigned)(size_t)F.lds + (unsigned)F.wave * 1024u;
#define DA_DMA(kt, slot) do { const size_t o_ = (size_t)(kt) * 64 * INW; const unsigned d_ = (unsigned)__builtin_amdgcn_readfirstlane(lds0 + (unsigned)(slot) * SLOT); \
        glds16(ksrc + o_, d_); glds16(ksrc + o_ + 64, d_ + 8192u); glds16(vsrc + o_, d_ + 16384u); glds16(vsrc + o_ + (size_t)32 * INW, d_ + 24576u); } while (0)
    const float cr = 8.0f * slope, thr = 40.0f / c1;
    float qk_ub;
    { float q2 = 0.f;
#pragma unroll
      for (int ks = 0; ks < 4; ++ks)
#pragma unroll
          for (int j = 0; j < 8; ++j) { const float v = __uint_as_float(((unsigned)(unsigned short)qf[ks][j]) << 16); q2 += v * v; }
      q2 += other_half(q2, hh);
      unsigned* km = (unsigned*)(F.ctl + CW_KMAX + 64 * l + b * 16 + (h * 2 + map) * 2);
      const float k2 = __uint_as_float(__hip_atomic_load(km, __ATOMIC_RELAXED, __HIP_MEMORY_SCOPE_AGENT)) + __uint_as_float(__hip_atomic_load(km + 1, __ATOMIC_RELAXED, __HIP_MEMORY_SCOPE_AGENT));
      qk_ub = sqrtf(q2) * sqrtf(k2) * 1.02f; }
    asm volatile("" ::: "memory");
    const int kt_hi = (q0 + 127) >> 6;
    DA_DMA(kt_hi, 0); DA_DMA(kt_hi - 1, 1); if (kt_hi >= 2) DA_DMA(kt_hi - 2, 2);
    float Bc[16];
#pragma unroll
    for (int r = 0; r < 16; ++r) Bc[r] = cr * (float)crow(r, hh);
    f32x16 o[4]; o[0] = f32x16{}; o[1] = f32x16{}; o[2] = f32x16{}; o[3] = f32x16{};
    float m_raw = -1e30f, l_run = 0.f;
    bool wdone = false;
#define DA_QK(S, VALID, kt_, Kb_) do { const int k0_ = (kt_) * 64; \
        if (!wdone) { const float dmin = (float)(qpos - (k0_ + 63)); if (__all((dmin > 0.f) && (qk_ub - cr * dmin < m_raw - thr))) wdone = true; } \
        VALID = !wdone && (k0_ <= qa + 31); \
        if (VALID) { const float A0 = -cr * (float)(qpos - k0_); \
            _Pragma("unroll") for (int sub = 0; sub < 2; ++sub) { \
                if (sub == 0 || (k0_ + 32 <= qa + 31)) { f32x16 sa; const float As = A0 + (float)(32 * sub) * cr; \
                    _Pragma("unroll") for (int r = 0; r < 16; ++r) sa[r] = As + Bc[r]; \
                    const int R = 32 * sub + r32; \
                    _Pragma("unroll") for (int ks = 0; ks < 4; ++ks) { const bf16x8 kfr = *(const LAS bf16x8*)((Kb_) + R * 128 + (((2 * ks + hh) ^ ((R >> 1) & 7)) << 4)); sa = MFMA32(kfr, qf[ks], sa); } \
                    S[sub] = sa; \
                } else { _Pragma("unroll") for (int r = 0; r < 16; ++r) S[sub][r] = -1e30f; } } \
            if (k0_ + 63 > qa) { \
                _Pragma("unroll") for (int sub = 0; sub < 2; ++sub) _Pragma("unroll") for (int r = 0; r < 16; ++r) if (k0_ + 32 * sub + crow(r, hh) > qpos) S[sub][r] = -1e30f; } \
        } } while (0)
    f32x16 sc[2], sn[2]; bool cvalid = false, nvalid = false;
    if (kt_hi >= 2) AT_WAIT_BAR(8); else AT_WAIT_BAR(4);
    DA_QK(sc, cvalid, kt_hi, F.lds + map * 8192);
    int slot = 0, nslot = 3;
    for (int kt = kt_hi; kt >= 0; --kt) {
        if (kt >= 2) AT_WAIT_BAR(4); else AT_WAIT_BAR(0);
        if (kt != kt_hi) { volatile LAS unsigned* fl = (volatile LAS unsigned*)(F.lds + MISC_OFF + 512) + (((kt + 1) & 1) << 3);
            const unsigned any_left = (fl[0] | fl[1]) | (fl[2] | fl[3]) | (fl[4] | fl[5]) | (fl[6] | fl[7]);
            if (!any_left) break; }
        if (kt >= 3) DA_DMA(kt - 3, nslot);
        const int s1 = (slot == NS - 1) ? 0 : slot + 1;
        nvalid = false;
        if (kt >= 1) DA_QK(sn, nvalid, kt - 1, F.lds + s1 * SLOT + map * 8192);
        if (cvalid) {
            LAS unsigned char* Vb = F.lds + slot * SLOT + 16384;
            const bool sub1 = (kt * 64 + 32 <= qa + 31);
            float mx = fmaxf(fmaxf(sc[0][0], sc[0][1]), sc[0][2]);
#pragma unroll
            for (int r = 3; r < 16; ++r) mx = fmaxf(mx, sc[0][r]);
#pragma unroll
            for (int r = 0; r < 16; ++r) mx = fmaxf(mx, sc[1][r]);
            mx = fmaxf(mx, other_half(mx, hh));
            const float mnew = fmaxf(m_raw, mx);
            if (__any(mnew > m_raw)) { const float al = fexp2(c1 * (m_raw - mnew)); l_run *= al;
#pragma unroll
                for (int dt = 0; dt < 4; ++dt)
#pragma unroll
                    for (int r = 0; r < 16; ++r) o[dt][r] *= al;
                m_raw = mnew; }
            const float nm = -c1 * m_raw;
            float psum = 0.f;
#pragma unroll
            for (int sub = 0; sub < 2; ++sub)
#pragma unroll
                for (int r = 0; r < 16; ++r) { sc[sub][r] = fexp2(fmaf(sc[sub][r], c1, nm)); psum += sc[sub][r]; }
            l_run += psum;
#pragma unroll
            for (int sub = 0; sub < 2; ++sub) {
                if (sub == 0 || sub1) {
#pragma unroll
                    for (int st = 0; st < 2; ++st) {
                        u32x4 pw; pw.x = pk2(sc[sub][8 * st + 0], sc[sub][8 * st + 1]); pw.y = pk2(sc[sub][8 * st + 2], sc[sub][8 * st + 3]); pw.z = pk2(sc[sub][8 * st + 4], sc[sub][8 * st + 5]); pw.w = pk2(sc[sub][8 * st + 6], sc[sub][8 * st + 7]);
                        const bf16x8 pa = __builtin_bit_cast(bf16x8, pw);
#pragma unroll
                        for (int dt = 0; dt < 4; ++dt) {
                            const int wofs = ((dt ^ q4) << 6) + 32 * blk + 8 * p4;
                            const s16x4 lo = vtr(Vb + (32 * sub + 16 * st + 4 * hh + q4) * 256 + wofs);
                            const s16x4 hi = vtr(Vb + (32 * sub + 16 * st + 8 + 4 * hh + q4) * 256 + wofs);
                            const bf16x8 vfr = __builtin_shufflevector(lo, hi, 0, 1, 2, 3, 4, 5, 6, 7);
                            o[dt] = MFMA32(vfr, pa, o[dt]); }
                    }
                }
            }
        }
        { volatile LAS unsigned* fl = (volatile LAS unsigned*)(F.lds + MISC_OFF + 512) + ((kt & 1) << 3); if (F.lane == 0) fl[F.wave] = (wdone || kt == 0) ? 0u : 1u; }
        sc[0] = sn[0]; sc[1] = sn[1]; cvalid = nvalid;
        slot = s1; nslot = (nslot == NS - 1) ? 0 : nslot + 1;
    }
#undef DA_QK
#undef DA_DMA
    AT_WAIT_BAR(0);
    const float ltot = l_run + other_half(l_run, hh); const float linv = 1.0f / ltot;
    LAS float* ex = (LAS float*)F.lds;
    if (map == 1) {
#pragma unroll
        for (int dt = 0; dt < 4; ++dt)
#pragma unroll
            for (int r = 0; r < 16; ++r) ex[((wq * 4 + dt) * 16 + r) * 64 + F.lane] = o[dt][r] * linv;
    }
    __syncthreads();
    if (map == 0) {
        gfp lp = GIN(I_LAM) + (size_t)l * 256;
        const float d1 = wave_sum(lp[F.lane] * lp[64 + F.lane]), d2 = wave_sum(lp[128 + F.lane] * lp[192 + F.lane]);
        const float lam = expf(d1) - expf(d2) + a->lam_init[l];
        float ss = 0.f;
#pragma unroll
        for (int dt = 0; dt < 4; ++dt)
#pragma unroll
            for (int r = 0; r < 16; ++r) { const float v = o[dt][r] * linv - lam * ex[((wq * 4 + dt) * 16 + r) * 64 + F.lane]; o[dt][r] = v; ss += v * v; }
        ss += other_half(ss, hh);
        const float sc = (1.0f / sqrtf(ss * (1.0f / 128.0f) + EPS)) * (1.0f - a->lam_init[l]);
        gfp sg = GIN(I_SUBLN) + (size_t)l * 128;
        bf16_t* yrow = YB + (rowbase + qpos) * 512 + h * 128;
#pragma unroll
        for (int dt = 0; dt < 4; ++dt)
#pragma unroll
            for (int G4 = 0; G4 < 4; ++G4) { const int d = 32 * dt + 8 * G4 + 4 * hh; const f32x4 gg = *(const GAS f32x4*)(sg + d);
                u32x2 w; w.x = pk2(o[dt][4 * G4] * sc * gg[0], o[dt][4 * G4 + 1] * sc * gg[1]); w.y = pk2(o[dt][4 * G4 + 2] * sc * gg[2], o[dt][4 * G4 + 3] * sc * gg[3]);
                *(u32x2*)(yrow + d) = w; }
    }
    __syncthreads();
}

__device__ __forceinline__ void mixer_phase(Frame& F, ArgsP a, int l, int qrep, int ulo, int uhi) {
    volatile LAS int* qs = (volatile LAS int*)(F.lds + MISC_OFF + 640);
    const int home = (int)(xb_xcc_id() & 7u);
    unsigned* qbase = (unsigned*)(F.ctl + CW_Q + ((l * 2 + qrep) * 8) * 64);
    for (;;) {
        if (F.tid == 0) { int got = -1;
            for (int sidx = 0; sidx < 8 && got < 0; ++sidx) { const int q = (home + sidx) & 7; unsigned* hd = qbase + q * 64;
                if (__hip_atomic_load(hd, __ATOMIC_RELAXED, __HIP_MEMORY_SCOPE_AGENT) < (unsigned)(uhi - ulo)) {
                    const unsigned j = __hip_atomic_fetch_add(hd, 1u, __ATOMIC_RELAXED, __HIP_MEMORY_SCOPE_AGENT);
                    if (j < (unsigned)(uhi - ulo)) got = q * 256 + (int)j + ulo; } }
            qs[0] = got; }
        __syncthreads();
        const int tk = qs[0];
        __syncthreads();
        if (tk < 0) break;
        const int q = tk >> 8, j = tk & 255;
        if (j < 64) { const int hsel = q & 1; const int h = (j & 1) ? (hsel ? 1 : 0) : (hsel ? 2 : 3); da_unit(F, a, l, q >> 1, h, 31 - (j >> 1)); }
        else if (j < 128) { const int jj = j - 64; sb_unit(F, (q >> 1) * 128 + (4 * (q & 1) + (jj & 3)) * 16 + (15 - (jj >> 2))); }
        else { const int jj = j - 128; gmlp_unit(F, a, l, (q * 16 + (jj >> 2)) * 4 + (jj & 3)); }
    }
}

constexpr int PH_PER_LAYER = 8, N_PHASES = DEPTH * PH_PER_LAYER + 1;
__global__ void __launch_bounds__(NTHREADS, 2) fwd_kernel(Args args) {
    extern __shared__ __attribute__((aligned(16))) unsigned char lds_raw[];
    Frame F;
    F.lds = (LAS unsigned char*)lds_raw;
    F.tid = threadIdx.x; F.lane = F.tid & 63; F.wave = __builtin_amdgcn_readfirstlane(F.tid >> 6);
    F.G = gridDim.x; { const int bx = blockIdx.x; F.vcu = (F.G % 8 == 0) ? (bx % 8) * (F.G / 8) + bx / 8 : bx; }
    F.ws = args.ws; F.ctl = (gu32*)(args.ws + WS_CTL);
    volatile LAS unsigned* MISC = (volatile LAS unsigned*)(F.lds + MISC_OFF);
    for (int u = F.tid; u < 256; u += NTHREADS) MISC[u] = 0u;
    __syncthreads();
#if MK_MULTI
#define GRID_BAR() do { } while (0)
#else
    XcdBarrier bar = xcd_barrier_post((unsigned*)(F.ctl + CW_BAR), MISC + 8);
#define GRID_BAR() xcd_barrier(bar)
#endif
    const int lo = args.ph_lo, hi = args.ph_hi;
#ifndef PHASE_MASK
#define PHASE_MASK 0x1ff
#endif
#define IN(k) (lo <= (k) && (k) < hi && ((PHASE_MASK >> ((k) % PH_PER_LAYER + ((k) == DEPTH * PH_PER_LAYER ? 8 : 0))) & 1))
#define SEAM(k) do { if (IN((k) + 1)) { GRID_BAR(); if (PROBE_DUP == 99) GRID_BAR(); } } while (0)
    const Frame F0 = F;
    ArgsP args_p;
    LAS int* const PFX = (LAS int*)(F.lds + MISC_OFF + 1024);
    LAS int* const CNT = (LAS int*)(F.lds + MISC_OFF + 1024 + 4 * 192);
    for (int l = 0; l < DEPTH; ++l) {
        const int p0 = l * PH_PER_LAYER;
        F = phase_frame(F0);
        { ArgsP ap = (ArgsP)__builtin_amdgcn_kernarg_segment_ptr(); asm volatile("" : "+s"(ap)); args_p = ap; }
        int bx = blockIdx.x; asm volatile("" : "+s"(bx));
        bf16_t* const Wb = (bf16_t*)(F.ws + WS_W);
        bf16_t* const ACT = (bf16_t*)(F.ws + WS_ACT);
        bf16_t* const PROJ = (bf16_t*)(F.ws + WS_PROJ);
        bf16_t* const Y = (bf16_t*)(F.ws + WS_Y);
        if (IN(p0 + 0)) { REP(10) convert_weights(F, args_p, l); if (l == 0) norm_rows<0>(F, args_p, l); else { if (PROBE_DUP == 98) norm_rows<3>(F, args_p, l); norm_rows<1>(F, args_p, l); } SEAM(p0 + 0); }
        if (IN(p0 + 1)) { REP(1) { pg8::DenseOrder S; S.init(T, INW, DM, Wb + W_IN / 2, F.G, bx); pg8::EpiProj E{PROJ, (unsigned*)(F.ctl + CW_KMAX + 64 * l)};
            pg8::gemm_phase<pg8::EpiProj, pg8::DenseOrder, true>(F.lds, F.wave, ACT, DM, S, E); } SEAM(p0 + 1); }
        if (IN(p0 + 2)) { mixer_phase(F, args_p, l, 0, 0, 192);
            if (PROBE_DUP == 2) mixer_phase(F, args_p, l, 1, 0, 192);
            if (PROBE_DUP == 20) mixer_phase(F, args_p, l, 1, 0, 64);
            if (PROBE_DUP == 21) mixer_phase(F, args_p, l, 1, 64, 128);
            if (PROBE_DUP == 22) mixer_phase(F, args_p, l, 1, 128, 192);
            SEAM(p0 + 2); }
        if (IN(p0 + 3)) { REP(3) {
            { pg8::DenseOrder S; S.init(T, DM, 512, Wb + W_UP / 2, F.G, bx); pg8::EpiGate<true> E{ACT, PROJ + C_G};
              pg8::gemm_phase<pg8::EpiGate<true>, pg8::DenseOrder, false>(F.lds, F.wave, Y, 512, S, E); }
            { pg8::DenseOrder S; S.init(T, DM, 512, Wb + W_UP / 2 + (size_t)DM * 512, F.G, bx); pg8::EpiGate<false> E{ACT, PROJ + C_G + 1024};
              pg8::gemm_phase<pg8::EpiGate<false>, pg8::DenseOrder, false>(F.lds, F.wave, Y + (size_t)T * 512, 512, S, E); }
            { pg8::DenseOrder S; S.init(T, DM, 512, Wb + W_UP / 2 + (size_t)2 * DM * 512, F.G, bx); pg8::EpiGate<false> E{ACT, PROJ + C_G + 2048};
              pg8::gemm_phase<pg8::EpiGate<false>, pg8::DenseOrder, false>(F.lds, F.wave, Y + (size_t)2 * T * 512, 512, S, E); } }
            SEAM(p0 + 3); }
        if (IN(p0 + 4)) {
            if (PROBE_DUP == 97) { pg8::DenseOrder S; S.init(T, DM, DM, Wb + W_OUT / 2, F.G, bx); pg8::EpiGate<true> E{(bf16_t*)(F.ws + WS_YS), PROJ + C_G};
                pg8::gemm_phase<pg8::EpiGate<true>, pg8::DenseOrder, false>(F.lds, F.wave, ACT, DM, S, E); }
            { pg8::DenseOrder S; S.init(T, DM, DM, Wb + W_OUT / 2, F.G, bx); pg8::EpiRes E{(float*)(F.ws + WS_X), (float*)(F.ws + WS_X)};
            pg8::gemm_phase<pg8::EpiRes, pg8::DenseOrder, false>(F.lds, F.wave, ACT, DM, S, E); } SEAM(p0 + 4); }
        if (IN(p0 + 5)) { if (PROBE_DUP == 96) t2_phase<true>(F, args_p, l); t2_phase<false>(F, args_p, l); SEAM(p0 + 5); }
        if (IN(p0 + 6) || IN(p0 + 7)) {
            if (F.tid == 0) { int run = 0;
                for (int e = 0; e < NE; ++e) { const int c = (int)__hip_atomic_load((unsigned*)(F.ctl + CW_CNT + 64 * l + e), __ATOMIC_RELAXED, __HIP_MEMORY_SCOPE_AGENT); CNT[e] = c; PFX[e] = run; run += (c + 255) >> 8; }
                PFX[16] = run; }
            __syncthreads();
            if (F.tid < 160) { int e = 0;
#pragma unroll
                for (int j = 1; j < 16; ++j) e += (PFX[j] <= F.tid) ? 1 : 0;
                PFX[32 + F.tid] = e; }
            __syncthreads();
        }
        if (IN(p0 + 6)) { REP(6) { MoeOrder<true> S{F.G, bx, 4, PFX, CNT, Wb + W_13 / 2, (size_t)DM * DM * 2, DM, (const unsigned*)(F.ws + WS_LIST)};
            pg8::EpiMoe1 E{(bf16_t*)(F.ws + WS_H), (const float*)(F.ws + WS_WL)};
            pg8::gemm_phase<pg8::EpiMoe1, MoeOrder<true>, true, true>(F.lds, F.wave, ACT, DM, S, E); } SEAM(p0 + 6); }
        if (IN(p0 + 7)) { REP(7) { MoeOrder<false> S{F.G, bx, 4, PFX, CNT, Wb + W_2 / 2, (size_t)DM * DFF * 2, DFF, (const unsigned*)(F.ws + WS_LIST)};
            pg8::EpiMoe2 E{(bf16_t*)(F.ws + WS_YS), (const unsigned*)(F.ws + WS_LIST)};
            pg8::gemm_phase<pg8::EpiMoe2, MoeOrder<false>, true>(F.lds, F.wave, (const bf16_t*)(F.ws + WS_H), DFF, S, E); } SEAM(p0 + 7); }
    }
    F = phase_frame(F0);
    { ArgsP ap = (ArgsP)__builtin_amdgcn_kernarg_segment_ptr(); asm volatile("" : "+s"(ap)); args_p = ap; }
    if (IN(DEPTH * PH_PER_LAYER)) norm_rows<2>(F, args_p, 0);
#undef IN
#undef SEAM
}

extern "C" void kernel_launch(void* const* d_in, const int* in_sizes, int n_in, void* d_out, int out_size, void* d_ws, size_t ws_size, hipStream_t stream) {
    static int grid = 0;
    if (grid == 0) {
        if (n_in != 19 || in_sizes[0] != T * DM || out_size != T * DM || ws_size < WS_END) { fprintf(stderr, "kernel_launch: unexpected shapes / workspace (n_in %d, ws %zu); nothing launched\n", n_in, ws_size); grid = -1; return; }
        int dev = 0, cus = 0, per_cu = 0;
        if (hipGetDevice(&dev) != hipSuccess || hipDeviceGetAttribute(&cus, hipDeviceAttributeMultiprocessorCount, dev) != hipSuccess) { grid = -1; return; }
        if (hipFuncSetAttribute((const void*)fwd_kernel, hipFuncAttributeMaxDynamicSharedMemorySize, LDS_BYTES) != hipSuccess) { fprintf(stderr, "kernel_launch: hipFuncSetAttribute failed\n"); grid = -1; return; }
        if (hipOccupancyMaxActiveBlocksPerMultiprocessor(&per_cu, (const void*)fwd_kernel, NTHREADS, LDS_BYTES) != hipSuccess || per_cu < 1) fprintf(stderr, "kernel_launch: occupancy query reports %d\n", per_cu);
        (void)hipGetLastError();
        grid = cus;
        if (grid != 256) { fprintf(stderr, "kernel_launch: built for 256 CUs, found %d\n", cus); grid = -1; return; }
    }
    if (grid < 0) return;
    if (hipMemsetAsync((char*)d_ws + WS_CTL, 0, CTL_ZERO_BYTES, stream) != hipSuccess) return;
    Args a{};
    for (int i = 0; i < 19; ++i) a.in[i] = (const float*)d_in[i];
    a.out = (float*)d_out; a.ws = (unsigned char*)d_ws;
    for (int l = 0; l < DEPTH; ++l) a.lam_init[l] = (float)(0.8 - 0.6 * exp(-0.3 * (double)l));
#if MK_MULTI
    for (int p = 0; p < N_PHASES; ++p) { a.ph_lo = p; a.ph_hi = p + 1; hipLaunchKernelGGL(fwd_kernel, dim3(grid), dim3(NTHREADS), LDS_BYTES, stream, a); }
#else
    a.ph_lo = 0; a.ph_hi = N_PHASES;
    hipLaunchKernelGGL(fwd_kernel, dim3(grid), dim3(NTHREADS), LDS_BYTES, stream, a);
#endif
}
```

```cpp
#include <hip/hip_runtime.h>
#include <cstdio>
#include <cstdint>
#include <cmath>

#ifndef MK_MULTI
#define MK_MULTI 0
#endif

#ifndef PROBE_DUP
#define PROBE_DUP -1
#endif
#ifndef PROBE_T
#define PROBE_T -1
#endif
#define REP(k) for (int rep_ = 0; rep_ < ((PROBE_DUP == (k)) ? 2 : 1); ++rep_)
#define LAS __attribute__((address_space(3)))
#define GAS __attribute__((address_space(1)))
typedef unsigned short bf16_t;
typedef short bf16x8 __attribute__((ext_vector_type(8)));
typedef short s16x4 __attribute__((ext_vector_type(4)));
typedef float f32x2 __attribute__((ext_vector_type(2)));
typedef float f32x4 __attribute__((ext_vector_type(4)));
typedef float f32x16 __attribute__((ext_vector_type(16)));
typedef unsigned u32x2 __attribute__((ext_vector_type(2)));
typedef unsigned u32x4 __attribute__((ext_vector_type(4)));
typedef GAS unsigned gu32;

constexpr int NBATCH = 4, SEQ = 4096, DM = 1024, T = NBATCH * SEQ, DEPTH = 4;
constexpr int INW = 7168, NE = 16, DFF = 512;
constexpr int C_UA = 0, C_VA = 512, C_QB = 1024, C_KB = 1536, C_VB = 2048, C_QC = 2560, C_KC = 3072, C_VC = 3584, C_G = 4096;
constexpr float EPS = 1e-6f;
constexpr float LOG2E = 1.4426950408889634f;
constexpr int NWAVES = 8, NTHREADS = 512;
constexpr int LISTCAP = T;

constexpr size_t MiB = 1u << 20;
constexpr size_t WS_CTL = 0, CTL_ZERO_BYTES = 1 * MiB;
constexpr size_t WS_LIST = 1 * MiB;
constexpr size_t WS_WL = 2 * MiB;
constexpr size_t WS_W = 4 * MiB;
constexpr size_t W_IN = 0, W_UP = 14 * MiB, W_OUT = 17 * MiB, W_13 = 19 * MiB, W_2 = 51 * MiB, W_END = 67 * MiB;
constexpr size_t WS_X = 72 * MiB;
constexpr size_t WS_ACT = 136 * MiB;
constexpr size_t WS_Y = 168 * MiB;
constexpr size_t WS_PROJ = 216 * MiB;
constexpr size_t WS_H = WS_PROJ;
constexpr size_t WS_YS = WS_PROJ + 40 * MiB;
constexpr size_t WS_END = 440 * MiB;
constexpr int CW_BAR = 4096;
constexpr int CW_CNT = 16384;
constexpr int CW_ERR = 8;
constexpr int CW_KMAX = 17408;
constexpr int CW_Q = 17920;

constexpr int RING_BYTES = 131072;
constexpr int MISC_OFF = RING_BYTES;
constexpr int LDS_BYTES = 147456;

__device__ __forceinline__ unsigned pk2(float lo, float hi) { typedef __bf16 b2 __attribute__((ext_vector_type(2))); f32x2 v = {lo, hi}; b2 b = __builtin_convertvector(v, b2); return __builtin_bit_cast(unsigned, b); }
__device__ __forceinline__ float bf_lo(unsigned w) { return __uint_as_float(w << 16); }
__device__ __forceinline__ float bf_hi(unsigned w) { return __uint_as_float(w & 0xffff0000u); }
template <int CTRL> __device__ __forceinline__ float dpp_f(float v) { return __builtin_bit_cast(float, __builtin_amdgcn_update_dpp(0, __builtin_bit_cast(int, v), CTRL, 0xf, 0xf, true)); }
__device__ __forceinline__ float xor1_f(float v) { return dpp_f<0xB1>(v); }
__device__ __forceinline__ float xor2_f(float v) { return dpp_f<0x4E>(v); }
__device__ __forceinline__ float wave_sum(float v) {
    v += dpp_f<0xB1>(v); v += dpp_f<0x4E>(v); v += dpp_f<0x141>(v)  ; v += dpp_f<0x140>(v)  ;
    v += __builtin_bit_cast(float, __builtin_amdgcn_ds_swizzle(__builtin_bit_cast(int, v), 0x401F))  ;
    auto rr = __builtin_amdgcn_permlane32_swap(__float_as_uint(v), __float_as_uint(v), false, false);
    return __uint_as_float(rr[0]) + __uint_as_float(rr[1]);
}
__device__ __forceinline__ float other_half(float v, int hh) { auto rr = __builtin_amdgcn_permlane32_swap(__float_as_uint(v), __float_as_uint(v), false, false); return __uint_as_float(hh ? rr[0] : rr[1]); }
__device__ __forceinline__ float fexp2(float x) { return __builtin_amdgcn_exp2f(x); }
__device__ __forceinline__ float flog2(float x) { return __builtin_amdgcn_logf(x); }
__device__ __forceinline__ float frcp(float x) { return __builtin_amdgcn_rcpf(x); }
__device__ __forceinline__ float gelu_tanh(float x) { const float u = x * (1.0f + 0.044715f * x * x); return x * frcp(1.0f + fexp2(-2.3022081985f * u)); }
__device__ __forceinline__ float sigmoidf_(float x) { return frcp(1.0f + fexp2(-LOG2E * x)); }
__device__ __forceinline__ int crow(int r, int hi) { return (r & 3) + 8 * (r >> 2) + 4 * hi; }
typedef short v4i16_t __attribute__((ext_vector_type(4)));
__device__ __forceinline__ s16x4 vtr(LAS const unsigned char* p) { return __builtin_bit_cast(s16x4, __builtin_amdgcn_ds_read_tr16_b64_v4i16((LAS v4i16_t*)p)); }
#define MFMA32(a, b, c) __builtin_amdgcn_mfma_f32_32x32x16_bf16((a), (b), (c), 0, 0, 0)

namespace pg8 {
constexpr int BM = 256, BK = 64, HALF = 128, HTB = HALF * BK * 2, STAGE_BYTES = 8 * HTB, NXCD = 8, WGM = 8;
__host__ __device__ __forceinline__ int lds_byte(int r, int c) { const int st = (r >> 4) * 2 + (c >> 5), rr = r & 15, cc = c & 31, ob = rr * 64 + cc * 2; return st * 1024 + (ob ^ (((ob >> 9) & 1) << 5)); }
__host__ __device__ __forceinline__ void stage_rc(int b, int& R, int& C) { const int st = b / 1024, sb = b % 1024, swz = sb ^ (((sb >> 9) & 1) << 5); R = (st >> 1) * 16 + swz / 64; C = (st & 1) * 32 + (swz % 64) / 2; }
__host__ __device__ __forceinline__ int perm32(int rho) { const int n = rho >> 4, i = rho & 15; return 8 * (i >> 2) + 4 * n + (i & 3); }

struct Unit { int pm, pn; int e, base, n; };

struct DenseOrder {
    int nM, nN, nwg, G, c; const bf16_t* Bt; int K;
    __device__ void init(int M, int N, int K_, const bf16_t* Bt_, int G_, int c_) { nM = M / BM; nN = N / BM; nwg = nM * nN; G = G_; c = c_; Bt = Bt_; K = K_; }
    __device__ __forceinline__ bool next(int i, Unit& u) const {
        const long L = (long)i * G + c; if (L >= nwg) return false;
        int wgid = (int)L; { const int q = nwg / NXCD, r = nwg % NXCD, xcd = wgid % NXCD, off = wgid / NXCD; wgid = (xcd < r ? xcd * (q + 1) : r * (q + 1) + (xcd - r) * q) + off; }
        const int nig = WGM * nN, gid = wgid / nig, fm = gid * WGM, gsz = (nM - fm) < WGM ? (nM - fm) : WGM;
        u.pm = fm + ((wgid % nig) % gsz); u.pn = (wgid % nig) / gsz; u.e = 0; u.base = 0; u.n = 0; return true;
    }
    __device__ __forceinline__ const char* b_base(const Unit& u) const { return (const char*)Bt + (size_t)u.pn * (size_t)(BM * K * 2); }
    __device__ __forceinline__ unsigned a_row(const Unit& u, int r) const { return (unsigned)(u.pm * BM + r); }
    __device__ __forceinline__ size_t a_shift(const Unit&) const { return 0; }
};

template <class Epi, class Sched, bool ALIGN_EPI, bool GATHER = false>
__device__ __forceinline__ void gemm_phase(LAS unsigned char* lds, const int wave_id, const bf16_t* A, const int K, const Sched& S, const Epi& E) {
    int lane_ = (int)__builtin_amdgcn_mbcnt_hi(~0u, __builtin_amdgcn_mbcnt_lo(~0u, 0u)); asm volatile("" : "+v"(lane_));
    const int wid = wave_id, lane = lane_, tid = wid * 64 + lane, wr = wid >> 2, wc = wid & 3, fr = lane & 15, fq = lane >> 4;
    const int nt = K / BK;
    int RA[2], CA[2]; unsigned voffB[2], voffA[2];
#pragma unroll
    for (int i = 0; i < 2; ++i) { int R, C; stage_rc(tid * 16 + i * 8192, R, C); const int Rb = Epi::PERM ? ((R & ~31) + perm32(R & 31)) : R;
        RA[i] = R; CA[i] = C; voffB[i] = (unsigned)(Rb * K + C) * 2u; voffA[i] = (unsigned)(R * K + C) * 2u; }
    const size_t kstep = (size_t)(BK * 2);
    const size_t hstep = (size_t)HALF * K * 2;
    const size_t tstep = 2 * hstep;
    const unsigned ldsw = (unsigned)wid * 1024u;
    const int aoff = lds_byte(wr * 64 + fr, fq * 8), boff = lds_byte(wc * 32 + fr, fq * 8);
#define PG8_SA(b, h) (((b) * 2 + (h)) * HTB)
#define PG8_SB(b, h) ((4 + (b) * 2 + (h)) * HTB)
#define PG8_STAGE(bufoff, gbase, voff) do { _Pragma("unroll") for (int _i = 0; _i < 2; ++_i) \
        __builtin_amdgcn_global_load_lds((const unsigned*)((const char*)(gbase) + (voff)[_i]), (LAS unsigned*)(lds + (bufoff) + ldsw + _i * 8192), 16, 0, 0); } while (0)
#define PG8_LDA(dst, b, h) do { _Pragma("unroll") for (int m = 0; m < 4; ++m) _Pragma("unroll") for (int k = 0; k < 2; ++k) dst[m][k] = *(const LAS bf16x8*)(lds + PG8_SA(b, h) + aoff + m * 2048 + k * 1024); } while (0)
#define PG8_LDB(dst, b, h) do { _Pragma("unroll") for (int n = 0; n < 2; ++n) _Pragma("unroll") for (int k = 0; k < 2; ++k) dst[n][k] = *(const LAS bf16x8*)(lds + PG8_SB(b, h) + boff + n * 2048 + k * 1024); } while (0)
#define PG8_MMA(ai, bj, At, Bt) do { __builtin_amdgcn_s_setprio(1); _Pragma("unroll") for (int m = 0; m < 4; ++m) _Pragma("unroll") for (int n = 0; n < 2; ++n) _Pragma("unroll") for (int k = 0; k < 2; ++k) \
        acc[ai][bj][m][n] = __builtin_amdgcn_mfma_f32_16x16x32_bf16(Bt[n][k], At[m][k], acc[ai][bj][m][n], 0, 0, 0); __builtin_amdgcn_s_setprio(0); } while (0)
#define PG8_WAIT_V(n) asm volatile("s_waitcnt vmcnt(" #n ")" ::: "memory")
#define PG8_WAIT_L(n) asm volatile("s_waitcnt lgkmcnt(" #n ")" ::: "memory")
#define PG8_BAR __builtin_amdgcn_s_barrier()
#define PG8_SCHED __builtin_amdgcn_sched_barrier(0)
#define PG8_STA(bufoff, kb, h, nx) do { if constexpr (GATHER) { _Pragma("unroll") for (int _i = 0; _i < 2; ++_i) \
        __builtin_amdgcn_global_load_lds((const unsigned*)(Ab + (kb) + ((nx) ? vN[h][_i] : vA[h][_i])), (LAS unsigned*)(lds + (bufoff) + ldsw + _i * 8192), 16, 0, 0); } \
        else { PG8_STAGE(bufoff, ((nx) ? nA : cA) + (kb) + (h) * hstep, voffA); } } while (0)
#define PG8_AOFFS(dst, u) do { _Pragma("unroll") for (int _h = 0; _h < 2; ++_h) _Pragma("unroll") for (int _i = 0; _i < 2; ++_i) \
        dst[_h][_i] = (S.a_row((u), _h * HALF + RA[_i]) * (unsigned)K + (unsigned)CA[_i]) * 2u; } while (0)
    Unit cur, nxt; int ui = 0;
    if (!S.next(0, cur)) return;
    f32x4 acc[2][2][4][2];
#pragma unroll
    for (int a = 0; a < 2; ++a)
#pragma unroll
        for (int b = 0; b < 2; ++b)
#pragma unroll
            for (int m = 0; m < 4; ++m)
#pragma unroll
                for (int n = 0; n < 2; ++n) acc[a][b][m][n] = (f32x4){0.f, 0.f, 0.f, 0.f};
    bf16x8 At[4][2], B0[2][2], B1[2][2];
    unsigned vA[2][2], vN[2][2];
    const char* const Ab = (const char*)A;
    const char* cA = Ab; const char* nA = Ab;
    if constexpr (GATHER) { PG8_AOFFS(vA, cur); } else { cA = Ab + S.a_shift(cur) + (size_t)cur.pm * tstep; }
    const char* cB = S.b_base(cur);
    PG8_STAGE(PG8_SB(0, 0), cB, voffB); PG8_STAGE(PG8_SB(0, 1), cB + hstep, voffB); PG8_STA(PG8_SA(0, 0), 0, 0, false); PG8_STA(PG8_SA(0, 1), 0, 1, false);
    if (wr == 1) PG8_BAR;
    PG8_WAIT_V(2); PG8_BAR;
    PG8_STAGE(PG8_SB(1, 0), cB + kstep, voffB); PG8_STA(PG8_SA(1, 0), kstep, 0, false); PG8_STAGE(PG8_SB(1, 1), cB + hstep + kstep, voffB);
    PG8_WAIT_V(6); PG8_BAR;
    for (;;) {
        const bool has_next = S.next(ui + 1, nxt);
        if (!has_next) nxt = cur;
        if constexpr (GATHER) { PG8_AOFFS(vN, nxt); } else { nA = Ab + S.a_shift(nxt) + (size_t)nxt.pm * tstep; }
        const char* nB = has_next ? S.b_base(nxt) : cB;
        for (int t = 0; t < nt; t += 2) {
            const bool last = (t == nt - 2);
            const size_t k1 = (size_t)(t + 1) * kstep;
            const size_t k2 = last ? (size_t)0 : (size_t)(t + 2) * kstep; const char* b2 = last ? nB : cB + (size_t)(t + 2) * kstep;
            const size_t k3 = k2 + kstep; const char* b3 = b2 + kstep;
            PG8_LDB(B0, 0, 0); PG8_LDB(B1, 0, 1); PG8_SCHED; PG8_LDA(At, 0, 0); PG8_STA(PG8_SA(1, 1), k1, 1, false);
            PG8_WAIT_V(8); PG8_WAIT_L(0); PG8_BAR; PG8_MMA(0, 0, At, B0); PG8_MMA(0, 1, At, B1); PG8_BAR; PG8_SCHED;
            PG8_LDA(At, 0, 1); PG8_STAGE(PG8_SB(0, 0), b2, voffB); PG8_STAGE(PG8_SB(0, 1), b2 + hstep, voffB); PG8_STA(PG8_SA(0, 0), k2, 0, last);
            PG8_WAIT_V(8); PG8_WAIT_L(0); PG8_BAR; PG8_MMA(1, 0, At, B0); PG8_MMA(1, 1, At, B1); PG8_BAR; PG8_SCHED;
            PG8_LDB(B0, 1, 0); PG8_LDB(B1, 1, 1); PG8_SCHED; PG8_LDA(At, 1, 0); PG8_STA(PG8_SA(0, 1), k2, 1, last);
            PG8_WAIT_V(8); PG8_WAIT_L(0); PG8_BAR; PG8_MMA(0, 0, At, B0); PG8_MMA(0, 1, At, B1); PG8_BAR; PG8_SCHED;
            PG8_LDA(At, 1, 1); PG8_STAGE(PG8_SB(1, 0), b3, voffB); PG8_STAGE(PG8_SB(1, 1), b3 + hstep, voffB); PG8_STA(PG8_SA(1, 0), k3, 0, last);
            PG8_WAIT_V(8); PG8_WAIT_L(0); PG8_BAR; PG8_MMA(1, 0, At, B0); PG8_MMA(1, 1, At, B1); PG8_BAR; PG8_SCHED;
        }
        if constexpr (ALIGN_EPI) { if (wr == 0) PG8_BAR; }
        E(acc, cur, wr, wc, fr, fq);
        if (!has_next) break;
        if constexpr (!Epi::KEEP_ACC) {
#pragma unroll
        for (int a = 0; a < 2; ++a)
#pragma unroll
            for (int b = 0; b < 2; ++b)
#pragma unroll
                for (int m = 0; m < 4; ++m)
#pragma unroll
                    for (int n = 0; n < 2; ++n) acc[a][b][m][n] = (f32x4){0.f, 0.f, 0.f, 0.f}; }
        cur = nxt; cB = nB; cA = nA; ++ui;
        if constexpr (GATHER) {
#pragma unroll
            for (int h = 0; h < 2; ++h)
#pragma unroll
                for (int i = 0; i < 2; ++i) vA[h][i] = vN[h][i]; }
        if constexpr (ALIGN_EPI) { if (wr == 1) PG8_BAR; }
    }
    PG8_WAIT_V(0);
    if constexpr (!ALIGN_EPI) { if (wr == 0) PG8_BAR; }
    PG8_BAR;
#undef PG8_SA
#undef PG8_SB
#undef PG8_STAGE
#undef PG8_LDA
#undef PG8_LDB
#undef PG8_MMA
#undef PG8_WAIT_V
#undef PG8_WAIT_L
#undef PG8_BAR
#undef PG8_SCHED
#undef PG8_AOFFS
#undef PG8_STA
}

struct EpiProj {
    static constexpr bool PERM = true, KEEP_ACC = false;
    bf16_t* O; unsigned* KM;
    __device__ __forceinline__ void operator()(f32x4 (&acc)[2][2][4][2], const Unit& u, int wr, int wc, int fr, int fq) const {
        const int row0 = u.pm * BM + wr * 64 + fr, col0 = u.pn * BM + wc * 32 + 8 * fq;
        const int mode = (u.pn < 4) ? 1 : (u.pn < 16 ? 0 : 2);
#pragma unroll
        for (int ai = 0; ai < 2; ++ai)
#pragma unroll
            for (int m = 0; m < 4; ++m) { bf16_t* rowp = O + (size_t)(row0 + ai * HALF + m * 16) * INW + col0;
#pragma unroll
                for (int bj = 0; bj < 2; ++bj) { f32x4 v0 = acc[ai][bj][m][0], v1 = acc[ai][bj][m][1];
                    if (mode == 1) {
#pragma unroll
                        for (int c = 0; c < 4; ++c) { v0[c] = gelu_tanh(v0[c]); v1[c] = gelu_tanh(v1[c]); }
                    } else if (mode == 2) {
#pragma unroll
                        for (int c = 0; c < 4; ++c) { v0[c] = sigmoidf_(v0[c]); v1[c] = sigmoidf_(v1[c]); }
                    }
                    u32x4 w; w.x = pk2(v0[0], v0[1]); w.y = pk2(v0[2], v0[3]); w.z = pk2(v1[0], v1[1]); w.w = pk2(v1[2], v1[3]);
                    *(u32x4*)(rowp + bj * HALF) = w; } }
        if (u.pn == 6 || u.pn == 7) {
            float mx[2] = {0.f, 0.f};
#pragma unroll
            for (int ai = 0; ai < 2; ++ai)
#pragma unroll
                for (int m = 0; m < 4; ++m)
#pragma unroll
                    for (int bj = 0; bj < 2; ++bj) { const f32x4 v0 = acc[ai][bj][m][0], v1 = acc[ai][bj][m][1];
                        float ss = (v0[0] * v0[0] + v0[1] * v0[1]) + (v0[2] * v0[2] + v0[3] * v0[3]) + (v1[0] * v1[0] + v1[1] * v1[1]) + (v1[2] * v1[2] + v1[3] * v1[3]);
                        ss += __builtin_bit_cast(float, __builtin_amdgcn_ds_swizzle(__builtin_bit_cast(int, ss), 0x401F));
                        { auto rr = __builtin_amdgcn_permlane32_swap(__float_as_uint(ss), __float_as_uint(ss), false, false); ss = __uint_as_float(rr[0]) + __uint_as_float(rr[1]); }
                        mx[bj] = fmaxf(mx[bj], ss); }
#pragma unroll
            for (int bj = 0; bj < 2; ++bj) { float v = mx[bj];
                v = fmaxf(v, dpp_f<0xB1>(v)); v = fmaxf(v, dpp_f<0x4E>(v)); v = fmaxf(v, dpp_f<0x141>(v)); v = fmaxf(v, dpp_f<0x140>(v));
                if (fr == 0 && fq == 0) __hip_atomic_fetch_max(KM + (u.pm >> 4) * 16 + (4 * (u.pn - 6) + 2 * bj + (wc >> 1)) * 2 + (wc & 1), __float_as_uint(v), __ATOMIC_RELAXED, __HIP_MEMORY_SCOPE_AGENT); }
        }
    }
};
struct EpiGate3 {
    static constexpr bool PERM = true, KEEP_ACC = true;
    bf16_t* P; const bf16_t* Gt;
    __device__ __forceinline__ void operator()(f32x4 (&acc)[2][2][4][2], const Unit& u, int wr, int wc, int fr, int fq) const {
        const int row0 = u.pm * BM + wr * 64 + fr, col0 = u.pn * BM + wc * 32 + 8 * fq; const int seg = u.e;
#pragma unroll
        for (int ai = 0; ai < 2; ++ai) { asm volatile("" ::: "memory");
#pragma unroll
            for (int m = 0; m < 4; ++m) { const int row = row0 + ai * HALF + m * 16;
#pragma unroll
                for (int bj = 0; bj < 2; ++bj) {
                    const bf16_t* gp = Gt + (size_t)row * INW + seg * 1024 + col0 + bj * HALF;
                    const u32x4 g = *(const u32x4*)gp;
                    float f[8] = {bf_lo(g.x), bf_hi(g.x), bf_lo(g.y), bf_hi(g.y), bf_lo(g.z), bf_hi(g.z), bf_lo(g.w), bf_hi(g.w)};
                    if (seg < 2) { const u32x4 gn = *(const u32x4*)(gp + 1024);
                        const float d[8] = {bf_lo(gn.x), bf_hi(gn.x), bf_lo(gn.y), bf_hi(gn.y), bf_lo(gn.z), bf_hi(gn.z), bf_lo(gn.w), bf_hi(gn.w)};
#pragma unroll
                        for (int c = 0; c < 8; ++c) f[c] = fmaxf(f[c], 1e-30f) * frcp(fmaxf(d[c], 1e-30f)); }
                    else {
#pragma unroll
                        for (int c = 0; c < 8; ++c) f[c] = fmaxf(f[c], 1e-30f); }
                    f32x4& a0 = acc[ai][bj][m][0]; f32x4& a1 = acc[ai][bj][m][1];
                    a0[0] *= f[0]; a0[1] *= f[1]; a0[2] *= f[2]; a0[3] *= f[3]; a1[0] *= f[4]; a1[1] *= f[5]; a1[2] *= f[6]; a1[3] *= f[7];
                    if (seg == 2) { u32x4 w; w.x = pk2(a0[0], a0[1]); w.y = pk2(a0[2], a0[3]); w.z = pk2(a1[0], a1[1]); w.w = pk2(a1[2], a1[3]);
                        *(u32x4*)(P + (size_t)row * DM + col0 + bj * HALF) = w; } } } }
    }
};
struct UpOrder {
    DenseOrder D; const bf16_t* Bt;
    __device__ __forceinline__ bool next(int i, Unit& u) const { if (i >= 3) return false; if (!D.next(0, u)) return false; u.e = i; return true; }
    __device__ __forceinline__ const char* b_base(const Unit& u) const { return (const char*)Bt + (size_t)u.e * (size_t)(DM * 512 * 2) + (size_t)u.pn * (size_t)(BM * 512 * 2); }
    __device__ __forceinline__ unsigned a_row(const Unit& u, int r) const { return (unsigned)(u.pm * BM + r); }
    __device__ __forceinline__ size_t a_shift(const Unit& u) const { return (size_t)u.e * (size_t)T * 512 * 2; }
};
struct EpiRes {
    static constexpr bool PERM = true, KEEP_ACC = false;
    float* X; float* XO;
    __device__ __forceinline__ void operator()(f32x4 (&acc)[2][2][4][2], const Unit& u, int wr, int wc, int fr, int fq) const {
        const int row0 = u.pm * BM + wr * 64 + fr, col0 = u.pn * BM + wc * 32 + 8 * fq;
#pragma unroll
        for (int ai = 0; ai < 2; ++ai) { asm volatile("" ::: "memory");
            f32x4 xv[4][2][2];
#pragma unroll
            for (int m = 0; m < 4; ++m)
#pragma unroll
                for (int bj = 0; bj < 2; ++bj) { const f32x4* p = (const f32x4*)(X + (size_t)(row0 + ai * HALF + m * 16) * DM + col0 + bj * HALF); xv[m][bj][0] = p[0]; xv[m][bj][1] = p[1]; }
#pragma unroll
            for (int m = 0; m < 4; ++m)
#pragma unroll
                for (int bj = 0; bj < 2; ++bj) { f32x4* po = (f32x4*)(XO + (size_t)(row0 + ai * HALF + m * 16) * DM + col0 + bj * HALF);
                    po[0] = xv[m][bj][0] + acc[ai][bj][m][0]; po[1] = xv[m][bj][1] + acc[ai][bj][m][1]; } }
    }
};
struct EpiMoe1 {
    static constexpr bool PERM = true, KEEP_ACC = false;
    bf16_t* H; const float* WL;
    __device__ __forceinline__ void operator()(f32x4 (&acc)[2][2][4][2], const Unit& u, int wr, int wc, int fr, int fq) const {
        const int r0 = wr * 64 + fr, col0 = u.pn * HALF + wc * 32 + 8 * fq;
#pragma unroll
        for (int ai = 0; ai < 2; ++ai)
#pragma unroll
            for (int m = 0; m < 4; ++m) { const int r = r0 + ai * HALF + m * 16; const int li = u.base + r;
                const float wt = (li < u.n) ? WL[(size_t)u.e * LISTCAP + li] : 0.f;
                const f32x4 a0 = acc[ai][0][m][0], a1 = acc[ai][0][m][1], b0 = acc[ai][1][m][0], b1 = acc[ai][1][m][1];
                float o[8];
#pragma unroll
                for (int c = 0; c < 4; ++c) { o[c] = a0[c] * sigmoidf_(a0[c]) * b0[c] * wt; o[4 + c] = a1[c] * sigmoidf_(a1[c]) * b1[c] * wt; }
                u32x4 w; w.x = pk2(o[0], o[1]); w.y = pk2(o[2], o[3]); w.z = pk2(o[4], o[5]); w.w = pk2(o[6], o[7]);
                *(u32x4*)(H + (size_t)(u.pm * BM + r) * DFF + col0) = w; }
    }
};
struct EpiMoe2 {
    static constexpr bool PERM = true, KEEP_ACC = false;
    bf16_t* YS; const unsigned* LIST;
    __device__ __forceinline__ void operator()(f32x4 (&acc)[2][2][4][2], const Unit& u, int wr, int wc, int fr, int fq) const {
        const int r0 = wr * 64 + fr, col0 = u.pn * BM + wc * 32 + 8 * fq;
        unsigned ent[2][4];
#pragma unroll
        for (int ai = 0; ai < 2; ++ai)
#pragma unroll
            for (int m = 0; m < 4; ++m) { const int li = u.base + r0 + ai * HALF + m * 16; ent[ai][m] = (li < u.n) ? LIST[(size_t)u.e * LISTCAP + li] : 0xffffffffu; }
#pragma unroll
        for (int ai = 0; ai < 2; ++ai)
#pragma unroll
            for (int m = 0; m < 4; ++m) {
                if (ent[ai][m] != 0xffffffffu) { const unsigned tok = ent[ai][m] & 0x7fffffffu, slot = ent[ai][m] >> 31;
                    bf16_t* rowp = YS + ((size_t)slot * T + tok) * DM + col0;
#pragma unroll
                    for (int bj = 0; bj < 2; ++bj) { const f32x4 v0 = acc[ai][bj][m][0], v1 = acc[ai][bj][m][1];
                        u32x4 w; w.x = pk2(v0[0], v0[1]); w.y = pk2(v0[2], v0[3]); w.z = pk2(v1[0], v1[1]); w.w = pk2(v1[2], v1[3]);
                        *(u32x4*)(rowp + bj * HALF) = w; } } }
    }
};
}

template <bool GATHER> struct MoeOrder {
    int G, c, npn; const LAS int* PFX; const LAS int* CNT; const bf16_t* Bt; size_t estride; int K; const unsigned* LIST;
    __device__ __forceinline__ bool next(int i, pg8::Unit& u) const {
        const int L = i * G + c; const int rt = L / npn; if (rt >= PFX[16]) return false;
        const int e = PFX[32 + rt];
        u.pm = rt; u.pn = L % npn; u.e = e; u.base = (rt - PFX[e]) * 256; u.n = CNT[e]; return true;
    }
    __device__ __forceinline__ const char* b_base(const pg8::Unit& u) const { return (const char*)Bt + (size_t)u.e * estride + (size_t)u.pn * (size_t)(256 * K * 2); }
    __device__ __forceinline__ unsigned a_row(const pg8::Unit& u, int r) const {
        if (GATHER) { const int li = u.base + r; return (li < u.n) ? (LIST[(size_t)u.e * LISTCAP + li] & 0x7fffffffu) : 0u; }
        return (unsigned)(u.pm * 256 + r);
    }
    __device__ __forceinline__ size_t a_shift(const pg8::Unit&) const { return 0; }
};

#define XB_TMO      128
#define XB_XCNT(j)  (256  + 64 * (j))
#define XB_XSUB(j)  (1280 + 64 * (j))
#define XB_XGEN(j)  (2304 + 64 * (j))
#define XB_TOP      3328
#define XB_TOPGEN   3392
#define XCD_BAR_WORDS 3456
#define XB_SPIN_CAP (1u << 18)
__device__ __forceinline__ unsigned xb_ld(unsigned* p)              { return __hip_atomic_load(p, __ATOMIC_RELAXED, __HIP_MEMORY_SCOPE_AGENT); }
__device__ __forceinline__ unsigned xb_add(unsigned* p, unsigned v) { return __hip_atomic_fetch_add(p, v, __ATOMIC_RELAXED, __HIP_MEMORY_SCOPE_AGENT); }
__device__ __forceinline__ unsigned xb_xcc_id() { return (unsigned)__builtin_amdgcn_s_getreg((3 << 11) | 20) & 0xFu; }
#define XB_SPIN(cond, bar) do { unsigned _sp = 0; while (cond) { __builtin_amdgcn_s_sleep(1); \
    if ((++_sp & 255u) == 0u) { if (xb_ld(&(bar)[XB_TMO])) break; if (_sp > XB_SPIN_CAP) { atomicAdd(&(bar)[XB_TMO], 1u); break; } } } } while (0)
struct XcdBarrier { unsigned* bar; unsigned x; volatile LAS unsigned* st; };
__device__ __forceinline__ XcdBarrier xcd_barrier_post(unsigned* bar, volatile LAS unsigned* st) {
    XcdBarrier b; b.bar = bar; b.x = xb_xcc_id(); b.st = st;
    if (threadIdx.x == 0) (void)xb_add(&bar[XB_XCNT(b.x)], 1u);
    return b;
}
__device__ __forceinline__ void xcd_barrier_complete(unsigned* bar, unsigned x, unsigned& nloc, unsigned& nx) {
    const unsigned G = gridDim.x * gridDim.y * gridDim.z;
    unsigned sum, cnt, mine, sp = 0u;
    for (;;) {
        sum = 0u; cnt = 0u; mine = 0u;
#pragma unroll
        for (unsigned j = 0; j < 16; ++j) { const unsigned c = xb_ld(&bar[XB_XCNT(j)]); sum += c; cnt += (c > 0u) ? 1u : 0u; mine = (j == x) ? c : mine; }
        if (sum == G) break;
        __builtin_amdgcn_s_sleep(1);
        if ((++sp & 255u) == 0u) { if (xb_ld(&bar[XB_TMO])) break; if (sp > XB_SPIN_CAP) { atomicAdd(&bar[XB_TMO], 1u); break; } }
    }
    nloc = mine > 0u ? mine : 1u; nx = cnt > 0u ? cnt : 1u;
}
__device__ __forceinline__ void xcd_barrier(const XcdBarrier& b) {
    asm volatile("s_waitcnt vmcnt(0)" ::: "memory");
    __syncthreads();
    if (threadIdx.x == 0) {
        unsigned* bar = b.bar;
        __builtin_amdgcn_s_waitcnt(0);
        unsigned nloc = b.st[0], nx = b.st[1];
        if (nloc == 0u) { xcd_barrier_complete(bar, b.x, nloc, nx); b.st[0] = nloc; b.st[1] = nx; }
        const unsigned old = xb_add(&bar[XB_XSUB(b.x)], 1u);
        const unsigned gen = old / nloc;
        if (old + 1u == (gen + 1u) * nloc) {
            __builtin_amdgcn_fence(__ATOMIC_RELEASE, "agent");
            asm volatile("s_waitcnt vmcnt(0)" ::: "memory");
            const unsigned og = xb_add(&bar[XB_TOP], 1u);
            const unsigned tg = og / nx;
            if (og + 1u == (tg + 1u) * nx) xb_add(&bar[XB_TOPGEN], 1u);
            else XB_SPIN(xb_ld(&bar[XB_TOPGEN]) == tg, bar);
            __builtin_amdgcn_fence(__ATOMIC_ACQUIRE, "agent");
            xb_add(&bar[XB_XGEN(b.x)], 1u);
            asm volatile("s_waitcnt vmcnt(0)" ::: "memory");
        } else {
            XB_SPIN(xb_ld(&bar[XB_XGEN(b.x)]) == gen, bar);
            __builtin_amdgcn_fence(__ATOMIC_ACQUIRE, "agent");
            asm volatile("s_waitcnt vmcnt(0)" ::: "memory");
        }
    }
    __syncthreads();
}

struct Args { const float* in[19]; float* out; unsigned char* ws; int ph_lo, ph_hi; float lam_init[4]; };
typedef const __attribute__((address_space(4))) Args* ArgsP;
typedef const GAS float* gfp;
#define GIN(i) ((gfp)a->in[i])
enum { I_X = 0, I_GMIX, I_WIN, I_WS, I_BS, I_GV, I_LAM, I_SUBLN, I_UPA, I_UPB, I_UPC, I_WOUT, I_GFFN, I_RW, I_RB, I_W1, I_W3, I_W2, I_FG };

struct Frame {
    LAS unsigned char* lds;
    gu32* ctl;
    int tid, lane, wave, vcu, G;
    unsigned char* ws;
};

__device__ __forceinline__ Frame phase_frame(const Frame& F0) {
    Frame F = F0; int ln = (int)__builtin_amdgcn_mbcnt_hi(~0u, __builtin_amdgcn_mbcnt_lo(~0u, 0u)); asm volatile("" : "+v"(ln)); F.lane = ln; F.tid = F0.wave * 64 + ln;
    size_t z = 0; asm volatile("" : "+s"(z)); unsigned char* w = F0.ws + z; F.ws = w; F.ctl = (gu32*)(w + WS_CTL);
    int v = F0.vcu, g = F0.G; asm volatile("" : "+s"(v), "+s"(g)); F.vcu = v; F.G = g;
    return F;
}
__device__ __forceinline__ void transpose_item(gfp W, int K, int N, bf16_t* WT, int rowT0, int k0, int n0, LAS float* scr, int lane) {
#pragma unroll 8
    for (int i = 0; i < 32; ++i) { const int kk = 2 * i + (lane >> 5); scr[kk * 33 + (lane & 31)] = W[(size_t)(k0 + kk) * N + n0 + (lane & 31)]; }
    asm volatile("s_waitcnt lgkmcnt(0)" ::: "memory");
    const int c = lane & 7;
#pragma unroll
    for (int j = 0; j < 4; ++j) { const int n = (lane >> 3) + 8 * j; const LAS float* s = scr + (8 * c) * 33 + n;
        u32x4 o; o.x = pk2(s[0 * 33], s[1 * 33]); o.y = pk2(s[2 * 33], s[3 * 33]); o.z = pk2(s[4 * 33], s[5 * 33]); o.w = pk2(s[6 * 33], s[7 * 33]);
        *(GAS u32x4*)(WT + (size_t)(rowT0 + n) * K + k0 + 8 * c) = o; }
    asm volatile("s_waitcnt lgkmcnt(0)" ::: "memory");
}
__device__ __forceinline__ void tr_matrix_item(gfp W, int K, int N, bf16_t* WT, int it, LAS float* scr, int lane) {
    const int nblk = N / 32, kb = it / nblk, nb = it % nblk;
    transpose_item(W, K, N, WT, 32 * nb, 64 * kb, 32 * nb, scr, lane);
}
__device__ __forceinline__ void convert_weights(const Frame& F_, ArgsP a, int l) {
    const Frame F = phase_frame(F_);
    LAS float* scr = (LAS float*)(F.lds + F.wave * 16384);
    const int gw = F.vcu * NWAVES + F.wave, NGW = F.G * NWAVES;
    bf16_t* Wb = (bf16_t*)(F.ws + WS_W);
    constexpr int I_IN = (DM / 64) * (INW / 32);
    constexpr int I_UP1 = (512 / 64) * (DM / 32);
    constexpr int I_OUT = (DM / 64) * (DM / 32);
    constexpr int I_E1 = (DM / 64) * (DFF / 32);
    constexpr int I_E2 = (DFF / 64) * (DM / 32);
    constexpr int I_EX = 2 * I_E1 + I_E2;
    constexpr int NITEMS = I_IN + 3 * I_UP1 + I_OUT + NE * I_EX;
    for (int it = gw; it < NITEMS; it += NGW) {
        int r = it;
        if (r < I_IN) { tr_matrix_item(GIN(I_WIN) + (size_t)l * DM * INW, DM, INW, Wb + W_IN / 2, r, scr, F.lane); continue; } r -= I_IN;
        if (r < 3 * I_UP1) { const int s = r / I_UP1; tr_matrix_item(GIN(I_UPA + s) + (size_t)l * 512 * DM, 512, DM, Wb + W_UP / 2 + (size_t)s * DM * 512, r % I_UP1, scr, F.lane); continue; } r -= 3 * I_UP1;
        if (r < I_OUT) { tr_matrix_item(GIN(I_WOUT) + (size_t)l * DM * DM, DM, DM, Wb + W_OUT / 2, r, scr, F.lane); continue; } r -= I_OUT;
        const int e = r / I_EX; r %= I_EX;
        if (r < 2 * I_E1) { const int which = r / I_E1; r %= I_E1;
            gfp W = GIN(which ? I_W3 : I_W1) + ((size_t)l * NE + e) * DM * DFF;
            const int nblk = DFF / 32, kb = r / nblk, nb = r % nblk, n0 = 32 * nb;
            transpose_item(W, DM, DFF, Wb + W_13 / 2 + (size_t)e * DM * DM, 256 * (n0 / 128) + 128 * which + (n0 % 128), 64 * kb, n0, scr, F.lane);
        } else { r -= 2 * I_E1;
            tr_matrix_item(GIN(I_W2) + ((size_t)l * NE + e) * DFF * DM, DFF, DM, Wb + W_2 / 2 + (size_t)e * DM * DFF, r, scr, F.lane); }
    }
}

template <int MODE  >
__device__ __forceinline__ void norm_rows(const Frame& F_, ArgsP a, int l) {
    const Frame F = phase_frame(F_);
    gfp gain = (MODE == 2) ? GIN(I_FG) : GIN(I_GMIX) + (size_t)l * DM;
    float* X = (float*)(F.ws + WS_X); bf16_t* XN = (bf16_t*)(F.ws + WS_ACT); const bf16_t* YS = (const bf16_t*)(F.ws + WS_YS);
    f32x4 g[4];
#pragma unroll
    for (int j = 0; j < 4; ++j) g[j] = *(const GAS f32x4*)(gain + 256 * j + 4 * F.lane);
    const int gw = F.vcu * NWAVES + F.wave, NGW = F.G * NWAVES;
    for (int m = gw; m < T; m += NGW) {
        gfp src = (MODE == 0) ? GIN(I_X) + (size_t)m * DM : (gfp)X + (size_t)m * DM;
        f32x4 v[4]; float ss = 0.f;
#pragma unroll
        for (int j = 0; j < 4; ++j) { v[j] = *(const GAS f32x4*)(src + 256 * j + 4 * F.lane);
            if (MODE != 0) {
                const u32x2 y0 = *(const u32x2*)(YS + (size_t)m * DM + 256 * j + 4 * F.lane), y1 = *(const u32x2*)(YS + ((size_t)T + m) * DM + 256 * j + 4 * F.lane);
                v[j][0] += bf_lo(y0.x) + bf_lo(y1.x); v[j][1] += bf_hi(y0.x) + bf_hi(y1.x); v[j][2] += bf_lo(y0.y) + bf_lo(y1.y); v[j][3] += bf_hi(y0.y) + bf_hi(y1.y); }
            ss += (v[j][0] * v[j][0] + v[j][1] * v[j][1]) + (v[j][2] * v[j][2] + v[j][3] * v[j][3]); }
        const float rstd = 1.0f / sqrtf(wave_sum(ss) * (1.0f / DM) + EPS);
#pragma unroll
        for (int j = 0; j < 4; ++j) {
            const f32x4 o = v[j] * rstd * g[j];
            if (MODE == 2) *(GAS f32x4*)((GAS float*)a->out + (size_t)m * DM + 256 * j + 4 * F.lane) = o;
            else { if (MODE != 3) *(f32x4*)(X + (size_t)m * DM + 256 * j + 4 * F.lane) = v[j];
                   u32x2 w; w.x = pk2(o[0], o[1]); w.y = pk2(o[2], o[3]); *(u32x2*)(XN + (size_t)m * DM + 256 * j + 4 * F.lane) = w; } }
    }
}

template <bool DRY> __device__ __forceinline__ void t2_phase(const Frame& F_, ArgsP a, int l) {
    const Frame F = phase_frame(F_);
    LAS float* RW = (LAS float*)(F.lds);
    LAS float* lsc = (LAS float*)(F.lds + 65536 + F.wave * 256);
    LAS int* lcnt = (LAS int*)(F.lds + 69632);
    LAS int* gbase = lcnt + 16;
    LAS int* tE = lcnt + 32;
    LAS int* tP = tE + 128;
    LAS float* tW = (LAS float*)(tP + 128);
    gfp rw = GIN(I_RW); gfp rb = GIN(I_RB); gfp gain = GIN(I_GFFN) + (size_t)l * DM;
    const float* X = (const float*)(F.ws + WS_X); bf16_t* XN = (bf16_t*)(F.ws + WS_ACT);
    unsigned* LIST = (unsigned*)(F.ws + WS_LIST); float* WL = (float*)(F.ws + WS_WL);
    for (int i = F.tid; i < DM * NE / 4; i += NTHREADS) { const f32x4 w = ((const GAS f32x4*)rw)[i]; const int k = i >> 2, e0 = (i & 3) * 4;
        RW[(e0 + 0) * DM + k] = w[0]; RW[(e0 + 1) * DM + k] = w[1]; RW[(e0 + 2) * DM + k] = w[2]; RW[(e0 + 3) * DM + k] = w[3]; }
    if (F.tid < 32) lcnt[F.tid] = 0;
    __syncthreads();
    f32x4 g[4];
#pragma unroll
    for (int j = 0; j < 4; ++j) g[j] = *(const GAS f32x4*)(gain + 256 * j + 4 * F.lane);
    const int rows_per_wg = T / F.G;
    const int row0 = F.vcu * rows_per_wg;
    constexpr int RB = 2;
#pragma unroll 1
    for (int bt = 0; bt < rows_per_wg / (NWAVES * RB); ++bt) {
        const int lr0 = (bt * NWAVES + F.wave) * RB;
        float hn[RB][16];
#pragma unroll
        for (int r = 0; r < RB; ++r) { const int m = row0 + lr0 + r; f32x4 v[4]; float ss = 0.f;
#pragma unroll
            for (int j = 0; j < 4; ++j) { v[j] = *(const f32x4*)(X + (size_t)m * DM + 256 * j + 4 * F.lane); ss += (v[j][0] * v[j][0] + v[j][1] * v[j][1]) + (v[j][2] * v[j][2] + v[j][3] * v[j][3]); }
            const float rstd = 1.0f / sqrtf(wave_sum(ss) * (1.0f / DM) + EPS);
#pragma unroll
            for (int j = 0; j < 4; ++j) { const f32x4 o = v[j] * rstd * g[j];
                hn[r][4 * j + 0] = o[0]; hn[r][4 * j + 1] = o[1]; hn[r][4 * j + 2] = o[2]; hn[r][4 * j + 3] = o[3];
                u32x2 w; w.x = pk2(o[0], o[1]); w.y = pk2(o[2], o[3]); *(u32x2*)(XN + (size_t)m * DM + 256 * j + 4 * F.lane) = w; } }
        float acc[RB][16];
#pragma unroll
        for (int r = 0; r < RB; ++r)
#pragma unroll
            for (int e = 0; e < 16; ++e) acc[r][e] = 0.f;
#pragma unroll
        for (int j = 0; j < 4; ++j)
#pragma unroll
            for (int eg = 0; eg < 4; ++eg) { asm volatile("" ::: "memory");
                f32x4 w4[4];
#pragma unroll
                for (int q = 0; q < 4; ++q) w4[q] = *(const LAS f32x4*)(RW + (4 * eg + q) * DM + 256 * j + 4 * F.lane);
#pragma unroll
                for (int r = 0; r < RB; ++r)
#pragma unroll
                    for (int q = 0; q < 4; ++q) acc[r][4 * eg + q] += (hn[r][4 * j + 0] * w4[q][0] + hn[r][4 * j + 1] * w4[q][1]) + (hn[r][4 * j + 2] * w4[q][2] + hn[r][4 * j + 3] * w4[q][3]);
#pragma unroll
                for (int r = 0; r < RB; ++r) asm volatile("" : "+v"(acc[r][0]), "+v"(acc[r][1]), "+v"(acc[r][2]), "+v"(acc[r][3]), "+v"(acc[r][4]), "+v"(acc[r][5]), "+v"(acc[r][6]), "+v"(acc[r][7]),
                    "+v"(acc[r][8]), "+v"(acc[r][9]), "+v"(acc[r][10]), "+v"(acc[r][11]), "+v"(acc[r][12]), "+v"(acc[r][13]), "+v"(acc[r][14]), "+v"(acc[r][15])); }
#pragma unroll
        for (int r = 0; r < RB; ++r)
#pragma unroll
            for (int e = 0; e < 16; ++e) { const float s = wave_sum(acc[r][e]); if (F.lane == 0) lsc[r * 16 + e] = s; }
        asm volatile("s_waitcnt lgkmcnt(0)" ::: "memory");
        if (F.lane < RB) {
            const int r = F.lane; LAS float* lg = lsc + r * 16;
            float best_gs = -1e30f; int best = 0;
#pragma unroll
            for (int gI = 0; gI < 4; ++gI) { float m1 = -1e30f, m2 = -1e30f;
#pragma unroll
                for (int i = 0; i < 4; ++i) { const float af = 1.0f / (1.0f + expf(-lg[4 * gI + i])); const float s = af + rb[4 * gI + i];
                    if (s > m1) { m2 = m1; m1 = s; } else if (s > m2) m2 = s; }
                const float gs = m1 + m2; if (gs > best_gs) { best_gs = gs; best = gI; } }
            float s1 = -1e30f, s2 = -1e30f; int i1 = 0, i2 = 0; float a1 = 0.f, a2 = 0.f;
#pragma unroll
            for (int i = 0; i < 4; ++i) { const float af = 1.0f / (1.0f + expf(-lg[4 * best + i])); const float s = af + rb[4 * best + i];
                if (s > s1) { s2 = s1; i2 = i1; a2 = a1; s1 = s; i1 = i; a1 = af; } else if (s > s2) { s2 = s; i2 = i; a2 = af; } }
            const int e0 = 4 * best + i1, e1 = 4 * best + i2; const float inv = 1.0f / (a1 + a2);
            const int lr = lr0 + r;
            tE[lr] = e0; tE[64 + lr] = e1; tW[lr] = a1 * inv; tW[64 + lr] = a2 * inv;
            tP[lr] = atomicAdd((int*)&lcnt[e0], 1); tP[64 + lr] = atomicAdd((int*)&lcnt[e1], 1);
        }
    }
    __syncthreads();
    if (DRY) { if (F.tid < 16) gbase[F.tid] = 0; } else if (F.tid < 16) gbase[F.tid] = (int)__hip_atomic_fetch_add((unsigned*)(F.ctl + CW_CNT + 64 * l + F.tid), (unsigned)lcnt[F.tid], __ATOMIC_RELAXED, __HIP_MEMORY_SCOPE_AGENT);
    __syncthreads();
    if (!DRY && F.tid < 2 * rows_per_wg) { const int slot = F.tid / rows_per_wg, lr = F.tid % rows_per_wg; const int e = tE[slot * 64 + lr]; const int pos = gbase[e] + tP[slot * 64 + lr];
        LIST[(size_t)e * LISTCAP + pos] = (unsigned)(row0 + lr) | ((unsigned)slot << 31); WL[(size_t)e * LISTCAP + pos] = tW[slot * 64 + lr]; }
    __syncthreads();
}

__device__ __forceinline__ void gmlp_unit(const Frame& F_, ArgsP a, int l, int unit) {
    const Frame F = phase_frame(F_);
    constexpr int VST = 320;
    const int c = unit >> 2, g = unit & 3; const int t0 = c * 128;
    const bf16_t* PROJ = (const bf16_t*)(F.ws + WS_PROJ); bf16_t* YA = (bf16_t*)(F.ws + WS_Y);
    LAS unsigned char* gv = F.lds; LAS float* rs = (LAS float*)(F.lds + 40960);
    {
        const int row = F.tid >> 2, qt = F.tid & 3; const bf16_t* p = PROJ + (size_t)(t0 + row) * INW + C_VA + qt * 128; float ss = 0.f;
#pragma unroll
        for (int i = 0; i < 16; ++i) { const u32x4 w = *(const u32x4*)(p + 8 * i);
            ss += bf_lo(w.x) * bf_lo(w.x) + bf_hi(w.x) * bf_hi(w.x) + bf_lo(w.y) * bf_lo(w.y) + bf_hi(w.y) * bf_hi(w.y) + bf_lo(w.z) * bf_lo(w.z) + bf_hi(w.z) * bf_hi(w.z) + bf_lo(w.w) * bf_lo(w.w) + bf_hi(w.w) * bf_hi(w.w); }
        ss += xor1_f(ss); ss += xor2_f(ss);
        if (qt == 0) rs[row] = 1.0f / sqrtf(ss * (1.0f / 512.0f) + EPS);
#pragma unroll
        for (int j = 0; j < 4; ++j) { const int id = F.tid + 512 * j, r = id >> 4, ch = id & 15;
            *(LAS u32x4*)(gv + r * VST + ch * 16) = *(const u32x4*)(PROJ + (size_t)(t0 + r) * INW + C_VA + g * 128 + ch * 8); }
    }
    __syncthreads();
    const int wt = F.wave >> 1, dh = F.wave & 1, r32 = F.lane & 31, hh = F.lane >> 5;
    const int q4 = (F.lane & 15) >> 2, p4 = F.lane & 3, blk = (F.lane >> 4) & 1;
    const int tl = 32 * wt + r32;
    gfp wrow = GIN(I_WS) + (((size_t)l * 4 + g) * 128 + tl) * 128;
    f32x16 acc[2]; acc[0] = f32x16{}; acc[1] = f32x16{};
    f32x4 wv4[8][2];
#pragma unroll
    for (int ks = 0; ks < 8; ++ks) if (16 * ks <= 32 * wt + 31) { wv4[ks][0] = *(const GAS f32x4*)(wrow + 16 * ks + 8 * hh); wv4[ks][1] = *(const GAS f32x4*)(wrow + 16 * ks + 8 * hh + 4); }
#pragma unroll
    for (int ks = 0; ks < 8; ++ks) {
        if (16 * ks <= 32 * wt + 31) {
        const int s0 = 16 * ks + 8 * hh;
        const f32x4 w0 = wv4[ks][0], w1 = wv4[ks][1];
        const f32x4 r0 = *(const LAS f32x4*)(rs + s0), r1 = *(const LAS f32x4*)(rs + s0 + 4);
        float wv[8];
#pragma unroll
        for (int j = 0; j < 4; ++j) { wv[j] = (s0 + j <= tl) ? w0[j] * r0[j] : 0.f; wv[4 + j] = (s0 + 4 + j <= tl) ? w1[j] * r1[j] : 0.f; }
        u32x4 wp; wp.x = pk2(wv[0], wv[1]); wp.y = pk2(wv[2], wv[3]); wp.z = pk2(wv[4], wv[5]); wp.w = pk2(wv[6], wv[7]);
        const bf16x8 wfr = __builtin_bit_cast(bf16x8, wp);
#pragma unroll
        for (int di = 0; di < 2; ++di) { const int dt = 2 * dh + di;
            const s16x4 lo = vtr(gv + (16 * ks + 8 * hh + q4) * VST + 64 * dt + 32 * blk + 8 * p4);
            const s16x4 hi = vtr(gv + (16 * ks + 8 * hh + 4 + q4) * VST + 64 * dt + 32 * blk + 8 * p4);
            const bf16x8 gfr = __builtin_shufflevector(lo, hi, 0, 1, 2, 3, 4, 5, 6, 7);
            acc[di] = MFMA32(gfr, wfr, acc[di]); }
        }
    }
    const float bias = GIN(I_BS)[((size_t)l * 4 + g) * 128 + tl];
    gfp gvg = GIN(I_GV) + (size_t)l * 512 + g * 128;
    const bf16_t* urow = PROJ + (size_t)(t0 + tl) * INW + C_UA + g * 128; bf16_t* yrow = YA + (size_t)(t0 + tl) * 512 + g * 128;
#pragma unroll
    for (int di = 0; di < 2; ++di)
#pragma unroll
        for (int G4 = 0; G4 < 4; ++G4) { const int d = 32 * (2 * dh + di) + 8 * G4 + 4 * hh;
            const f32x4 gg = *(const GAS f32x4*)(gvg + d); const u32x2 uu = *(const u32x2*)(urow + d);
            const float o0 = bf_lo(uu.x) * (acc[di][4 * G4 + 0] * gg[0] + bias), o1 = bf_hi(uu.x) * (acc[di][4 * G4 + 1] * gg[1] + bias);
            const float o2 = bf_lo(uu.y) * (acc[di][4 * G4 + 2] * gg[2] + bias), o3 = bf_hi(uu.y) * (acc[di][4 * G4 + 3] * gg[3] + bias);
            u32x2 w; w.x = pk2(o0, o1); w.y = pk2(o2, o3); *(u32x2*)(yrow + d) = w; }
    __syncthreads();
}

__device__ __forceinline__ void glds16(const void* sbase, unsigned voff, unsigned lds_dst) { unsigned keep;
    asm volatile("s_mov_b32 %0, m0\n\ts_mov_b32 m0, %3\n\ts_nop 0\n\tglobal_load_lds_dwordx4 %1, %2\n\ts_mov_b32 m0, %0" : "=&s"(keep) : "v"(voff), "s"(sbase), "s"(lds_dst) : "memory"); }
#define AT_WAIT_BAR(N) asm volatile("s_waitcnt vmcnt(" #N ") lgkmcnt(0)\n\ts_barrier" ::: "memory")

__device__ __forceinline__ void sb_unit(const Frame& F_, int unit) {
    const Frame F = phase_frame(F_);
    constexpr int SLOT = 16384, NS = 4;
    const int b = unit >> 7, h = (unit >> 4) & 7, qb = unit & 15;
    const bf16_t* PROJ = (const bf16_t*)(F.ws + WS_PROJ); bf16_t* YC = (bf16_t*)(F.ws + WS_Y) + (size_t)2 * T * 512;
    const size_t rowbase = (size_t)b * SEQ; const int q0 = qb * 256;
    const int r32 = F.lane & 31, hh = F.lane >> 5, q4 = (F.lane & 15) >> 2, p4 = F.lane & 3, blk = (F.lane >> 4) & 1;
    const int qa = q0 + 32 * F.wave, qpos = qa + r32;
    bf16x8 qf[4];
#pragma unroll
    for (int ks = 0; ks < 4; ++ks) qf[ks] = *(const bf16x8*)(PROJ + (rowbase + qpos) * INW + C_QC + h * 64 + 16 * ks + 8 * hh);
    const int drow = F.wave * 8 + (F.lane >> 3), dpos = F.lane & 7;
    const unsigned ksrc = (unsigned)(((rowbase + drow) * INW + C_KC + h * 64 + (dpos ^ ((drow >> 1) & 7)) * 8) * 2);
    const unsigned vsrc = (unsigned)(((rowbase + drow) * INW + C_VC + h * 64 + ((((dpos >> 2) ^ ((drow >> 1) & 1)) << 2) | (dpos & 3)) * 8) * 2);
    const unsigned lds0 = (unsigned)(size_t)F.lds + (unsigned)F.wave * 1024u;
#define SB_DMA(kt, slot) do { const char* b_ = (const char*)PROJ + (size_t)(kt) * 64 * INW * 2; const unsigned d_ = (unsigned)__builtin_amdgcn_readfirstlane(lds0 + (unsigned)(slot) * SLOT); glds16(b_, ksrc, d_); glds16(b_, vsrc, d_ + 8192u); } while (0)
    f32x16 o[2]; o[0] = f32x16{}; o[1] = f32x16{};
    float carry = 0.f; bool done = false;
    const int kt_hi = (q0 + 255) >> 6;
    SB_DMA(kt_hi, 0); SB_DMA(kt_hi - 1, 1); SB_DMA(kt_hi - 2, 2);
    int slot = 0, nslot = 3;
    for (int kt = kt_hi; kt >= 0; --kt) {
        const int k0 = kt * 64;
        if (kt >= 2) AT_WAIT_BAR(4); else if (kt == 1) AT_WAIT_BAR(2); else AT_WAIT_BAR(0);
        if (kt != kt_hi) { volatile LAS unsigned* fl = (volatile LAS unsigned*)(F.lds + MISC_OFF + 512) + (((kt + 1) & 1) << 3);
            const unsigned any_left = (fl[0] | fl[1]) | (fl[2] | fl[3]) | (fl[4] | fl[5]) | (fl[6] | fl[7]);
            if (!any_left) break; }
        if (kt >= 3) SB_DMA(kt - 3, nslot);
        LAS unsigned char* Kb = F.lds + slot * SLOT; LAS unsigned char* Vb = Kb + 8192;
        if (!done && k0 < qa + 31) {
#pragma unroll
            for (int sub = 1; sub >= 0; --sub) {
                const int kb0 = k0 + 32 * sub;
                if (kb0 < qa + 31) {
                    f32x16 sacc = f32x16{};
                    const int R = 32 * sub + r32;
#pragma unroll
                    for (int ks = 0; ks < 4; ++ks) { const bf16x8 kfr = *(const LAS bf16x8*)(Kb + R * 128 + (((2 * ks + hh) ^ ((R >> 1) & 7)) << 4)); sacc = MFMA32(kfr, qf[ks], sacc); }
                    float lk[16], lb[16];
#pragma unroll
                    for (int r = 0; r < 16; ++r) { const float z2 = sacc[r] * (0.125f * LOG2E); const float sp2 = fmaxf(z2, 0.f) + flog2(1.0f + fexp2(-fabsf(z2)));
                        const bool valid = (kb0 + crow(r, hh)) < qpos; lk[r] = valid ? -sp2 : 0.f; lb[r] = valid ? (z2 - sp2) : -1e30f; }
                    float gs[4], og[4];
#pragma unroll
                    for (int G4 = 0; G4 < 4; ++G4) { gs[G4] = (lk[4 * G4] + lk[4 * G4 + 1]) + (lk[4 * G4 + 2] + lk[4 * G4 + 3]); og[G4] = other_half(gs[G4], hh); }
                    float hi_sum = 0.f;
                    float av[16];
#pragma unroll
                    for (int G4 = 3; G4 >= 0; --G4) {
                        float suf = carry + hi_sum + (hh == 0 ? og[G4] : 0.f);
#pragma unroll
                        for (int cI = 3; cI >= 0; --cI) { av[4 * G4 + cI] = fexp2(lb[4 * G4 + cI] + suf); suf += lk[4 * G4 + cI]; }
                        hi_sum += gs[G4] + og[G4];
                    }
                    carry += hi_sum;
#pragma unroll
                    for (int s = 0; s < 2; ++s) {
                        u32x4 pw; pw.x = pk2(av[8 * s + 0], av[8 * s + 1]); pw.y = pk2(av[8 * s + 2], av[8 * s + 3]); pw.z = pk2(av[8 * s + 4], av[8 * s + 5]); pw.w = pk2(av[8 * s + 6], av[8 * s + 7]);
                        const bf16x8 pa = __builtin_bit_cast(bf16x8, pw);
#pragma unroll
                        for (int dt = 0; dt < 2; ++dt) {
                            const int wofs = ((dt ^ ((q4 >> 1) & 1)) << 6) + 32 * blk + 8 * p4;
                            const s16x4 lo = vtr(Vb + (32 * sub + 16 * s + 4 * hh + q4) * 128 + wofs);
                            const s16x4 hi = vtr(Vb + (32 * sub + 16 * s + 8 + 4 * hh + q4) * 128 + wofs);
                            const bf16x8 vfr = __builtin_shufflevector(lo, hi, 0, 1, 2, 3, 4, 5, 6, 7);
                            o[dt] = MFMA32(vfr, pa, o[dt]); }
                    }
                }
            }
            if (__all(carry < -45.0f)) done = true;
        }
        if (kt == 0) done = true;
        { volatile LAS unsigned* fl = (volatile LAS unsigned*)(F.lds + MISC_OFF + 512) + ((kt & 1) << 3); if (F.lane == 0) fl[F.wave] = done ? 0u : 1u; }
        slot = (slot == NS - 1) ? 0 : slot + 1; nslot = (nslot == NS - 1) ? 0 : nslot + 1;
    }
#undef SB_DMA
    bf16_t* yrow = YC + (rowbase + qpos) * 512 + h * 64;
#pragma unroll
    for (int dt = 0; dt < 2; ++dt)
#pragma unroll
        for (int G4 = 0; G4 < 4; ++G4) { u32x2 w; w.x = pk2(o[dt][4 * G4], o[dt][4 * G4 + 1]); w.y = pk2(o[dt][4 * G4 + 2], o[dt][4 * G4 + 3]);
            *(u32x2*)(yrow + 32 * dt + 8 * G4 + 4 * hh) = w; }
    AT_WAIT_BAR(0);
}

__device__ __forceinline__ void da_unit(const Frame& F_, ArgsP a, int l, int b, int h, int qblk) {
    const Frame F = phase_frame(F_);
    constexpr int SLOT = 32768, NS = 4;
    const bf16_t* PROJ = (const bf16_t*)(F.ws + WS_PROJ); bf16_t* YB = (bf16_t*)(F.ws + WS_Y) + (size_t)T * 512;
    const size_t rowbase = (size_t)b * SEQ; const int q0 = qblk * 128;
    const int map = F.wave >> 2, wq = F.wave & 3;
    const int r32 = F.lane & 31, hh = F.lane >> 5, q4 = (F.lane & 15) >> 2, p4 = F.lane & 3, blk = (F.lane >> 4) & 1;
    const int qa = q0 + 32 * wq, qpos = qa + r32;
    const float slope = (h == 0) ? 0.25f : (h == 1) ? 0.0625f : (h == 2) ? 0.015625f : 0.00390625f;
    const float c1 = 0.125f * LOG2E, c2 = slope * LOG2E;
    bf16x8 qf[4];
#pragma unroll
    for (int ks = 0; ks < 4; ++ks) qf[ks] = *(const bf16x8*)(PROJ + (rowbase + qpos) * INW + C_QB + h * 128 + map * 64 + 16 * ks + 8 * hh);
    const int krow = F.wave * 8 + (F.lane >> 3), kpos = F.lane & 7;
    const unsigned ksrc = (unsigned)(((rowbase + krow) * INW + C_KB + h * 128 + (kpos ^ ((krow >> 1) & 7)) * 8) * 2);
    const int vrow = F.wave * 4 + (F.lane >> 4), vpos = F.lane & 15;
    const unsigned vsrc = (unsigned)(((rowbase + vrow) * INW + C_VB + h * 128 + ((((vpos >> 2) ^ (vrow & 3)) << 2) | (vpos & 3)) * 8) * 2);
    const unsigned lds0 = (unsigned)(size_t)F.lds + (unsigned)F.wave * 1024u;
#define DA_DMA(kt, slot) do { const char* b_ = (const char*)PROJ + (size_t)(kt) * 64 * INW * 2; const unsigned d_ = (unsigned)__builtin_amdgcn_readfirstlane(lds0 + (unsigned)(slot) * SLOT); \
        glds16(b_, ksrc, d_); glds16(b_ + 128, ksrc, d_ + 8192u); glds16(b_, vsrc, d_ + 16384u); glds16(b_ + (size_t)32 * INW * 2, vsrc, d_ + 24576u); } while (0)
    const float cr = 8.0f * slope, thr = 40.0f / c1;
    float qk_ub;
    { float q2 = 0.f;
#pragma unroll
      for (int ks = 0; ks < 4; ++ks)
#pragma unroll
          for (int j = 0; j < 8; ++j) { const float v = __uint_as_float(((unsigned)(unsigned short)qf[ks][j]) << 16); q2 += v * v; }
      q2 += other_half(q2, hh);
      unsigned* km = (unsigned*)(F.ctl + CW_KMAX + 64 * l + b * 16 + (h * 2 + map) * 2);
      const float k2 = __uint_as_float(__hip_atomic_load(km, __ATOMIC_RELAXED, __HIP_MEMORY_SCOPE_AGENT)) + __uint_as_float(__hip_atomic_load(km + 1, __ATOMIC_RELAXED, __HIP_MEMORY_SCOPE_AGENT));
      qk_ub = sqrtf(q2) * sqrtf(k2) * 1.02f; }
    asm volatile("" ::: "memory");
    const int kt_hi = (q0 + 127) >> 6;
    DA_DMA(kt_hi, 0); DA_DMA(kt_hi - 1, 1);
    f32x16 o[4]; o[0] = f32x16{}; o[1] = f32x16{}; o[2] = f32x16{}; o[3] = f32x16{};
    float m_raw = -1e30f, l_run = 0.f;
    bool wdone = false;
    const int kro = r32 * 128, vro = (4 * hh + q4) * 256 + 32 * blk + 8 * p4;
    int kx[4], vx[4];
#pragma unroll
    for (int i = 0; i < 4; ++i) { kx[i] = kro + ((((2 * i + hh) ^ ((r32 >> 1) & 7))) << 4); vx[i] = vro + ((i ^ q4) << 6); }
#define SB() __builtin_amdgcn_sched_barrier(0)
#define DA_FLAG(kt_) do { volatile LAS unsigned* fl_ = (volatile LAS unsigned*)(F.lds + MISC_OFF + 512) + (((kt_) & 1) << 3); if (F.lane == 0) fl_[F.wave] = (wdone || (kt_) == 0) ? 0u : 1u; } while (0)
#define DA_VFR(Vb_, sub, st, dt) ({ const s16x4 lo_ = vtr((Vb_) + vx[dt] + (32 * (sub) + 16 * (st)) * 256); const s16x4 hi_ = vtr((Vb_) + vx[dt] + (32 * (sub) + 16 * (st) + 8) * 256); \
        (bf16x8)__builtin_shufflevector(lo_, hi_, 0, 1, 2, 3, 4, 5, 6, 7); })
    int kt = kt_hi, step = 0;
    bool alive = true;
    for (; step < 2 && kt >= 0; ++step, --kt) {
        const int k0 = kt * 64;
        if (kt >= 1) AT_WAIT_BAR(4); else AT_WAIT_BAR(0);
        if (kt >= 2) DA_DMA(kt - 2, (step + 2) & 3);
        LAS unsigned char* Kb = F.lds + (step & 3) * SLOT + map * 8192; LAS unsigned char* Vb = F.lds + (step & 3) * SLOT + 16384;
        if (k0 <= qa + 31) {
            f32x16 sc[2];
            const bool sub1 = (k0 + 32 <= qa + 31);
            const float A0 = -cr * (float)(qpos - k0);
#pragma unroll
            for (int sub = 0; sub < 2; ++sub) {
                if (sub == 0 || sub1) { f32x16 sa; const float As = A0 + (float)(32 * sub + 4 * hh) * cr;
#pragma unroll
                    for (int r = 0; r < 16; ++r) sa[r] = fmaf(cr, (float)((r & 3) + 8 * (r >> 2)), As);
#pragma unroll
                    for (int ks = 0; ks < 4; ++ks) { const bf16x8 kfr = *(const LAS bf16x8*)(Kb + kx[ks] + sub * 4096); sa = MFMA32(kfr, qf[ks], sa); }
#pragma unroll
                    for (int r = 0; r < 16; ++r) if (k0 + 32 * sub + crow(r, hh) > qpos) sa[r] = -1e30f;
                    sc[sub] = sa;
                } else {
#pragma unroll
                    for (int r = 0; r < 16; ++r) sc[sub][r] = -1e30f; } }
            float mx = sc[0][0];
#pragma unroll
            for (int r = 1; r < 16; ++r) mx = fmaxf(mx, sc[0][r]);
#pragma unroll
            for (int r = 0; r < 16; ++r) mx = fmaxf(mx, sc[1][r]);
            mx = fmaxf(mx, other_half(mx, hh));
            const float mnew = fmaxf(m_raw, mx);
            { const float al = fexp2(c1 * (m_raw - mnew)); l_run *= al;
#pragma unroll
              for (int dt = 0; dt < 4; ++dt)
#pragma unroll
                  for (int r = 0; r < 16; ++r) o[dt][r] *= al;
              m_raw = mnew; }
            const float nm = -c1 * m_raw;
            float psum = 0.f;
#pragma unroll
            for (int sub = 0; sub < 2; ++sub)
#pragma unroll
                for (int r = 0; r < 16; ++r) { sc[sub][r] = fexp2(fmaf(sc[sub][r], c1, nm)); psum += sc[sub][r]; }
            l_run += psum;
#pragma unroll
            for (int sub = 0; sub < 2; ++sub) {
                if (sub == 0 || sub1) {
#pragma unroll
                    for (int st = 0; st < 2; ++st) {
                        u32x4 pw; pw.x = pk2(sc[sub][8 * st + 0], sc[sub][8 * st + 1]); pw.y = pk2(sc[sub][8 * st + 2], sc[sub][8 * st + 3]); pw.z = pk2(sc[sub][8 * st + 4], sc[sub][8 * st + 5]); pw.w = pk2(sc[sub][8 * st + 6], sc[sub][8 * st + 7]);
                        const bf16x8 pa = __builtin_bit_cast(bf16x8, pw);
#pragma unroll
                        for (int dt = 0; dt < 4; ++dt) { const bf16x8 vfr = DA_VFR(Vb, sub, st, dt); o[dt] = MFMA32(vfr, pa, o[dt]); } } } }
        }
        DA_FLAG(kt);
    }
    f32x16 pp = f32x16{};
    bool pending = false; int pvoff = 16384;
#define DA_RETIRE() do { float rs_ = 0.f; \
        _Pragma("unroll") for (int r = 0; r < 16; ++r) rs_ += pp[r]; \
        l_run += rs_; \
        _Pragma("unroll") for (int st = 0; st < 2; ++st) { \
            u32x4 pw_; pw_.x = pk2(pp[8 * st + 0], pp[8 * st + 1]); pw_.y = pk2(pp[8 * st + 2], pp[8 * st + 3]); pw_.z = pk2(pp[8 * st + 4], pp[8 * st + 5]); pw_.w = pk2(pp[8 * st + 6], pp[8 * st + 7]); \
            _Pragma("unroll") for (int dt = 0; dt < 4; ++dt) { const bf16x8 vfr = DA_VFR(F.lds + pvoff, 0, st, dt); o[dt] = MFMA32(vfr, __builtin_bit_cast(bf16x8, pw_), o[dt]); } } \
        pending = false; } while (0)
    for (; kt >= 0; ++step, --kt) {
        const int k0 = kt * 64;
        if (kt >= 1) AT_WAIT_BAR(4); else AT_WAIT_BAR(0);
        { volatile LAS unsigned* fl = (volatile LAS unsigned*)(F.lds + MISC_OFF + 512) + (((kt + 1) & 1) << 3);
          const unsigned any_left = (fl[0] | fl[1]) | (fl[2] | fl[3]) | (fl[4] | fl[5]) | (fl[6] | fl[7]);
          if (!any_left) { alive = false; break; } }
        if (kt >= 2) DA_DMA(kt - 2, (step + 2) & 3);
        const int sbase = (step & 3) * SLOT;
        if (!wdone) { const float dmin = (float)(qpos - (k0 + 63)); if (__all(qk_ub - cr * dmin < m_raw - thr)) wdone = true; }
        if (!wdone) {
#pragma unroll
            for (int sub = 0; sub < 2; ++sub) {
                LAS unsigned char* Kb = F.lds + sbase + map * 8192 + sub * 4096;
                f32x16 sa;
                { const float A0 = -cr * (float)(qpos - k0) + (float)(4 * hh + 32 * sub) * cr;
#pragma unroll
                  for (int r = 0; r < 16; ++r) sa[r] = fmaf(cr, (float)((r & 3) + 8 * (r >> 2)), A0); }
                float rs = 0.f; u32x4 pw[2];
                bf16x8 kq[4];
#pragma unroll
                for (int ks = 0; ks < 4; ++ks) kq[ks] = *(const LAS bf16x8*)(Kb + kx[ks]);
                SB();
#pragma unroll
                for (int ks = 0; ks < 4; ++ks) {
                    sa = MFMA32(kq[ks], qf[ks], sa);
                    rs += (pp[4 * ks + 0] + pp[4 * ks + 1]) + (pp[4 * ks + 2] + pp[4 * ks + 3]);
                    if (ks & 1) { pw[ks >> 1].z = pk2(pp[4 * ks + 0], pp[4 * ks + 1]); pw[ks >> 1].w = pk2(pp[4 * ks + 2], pp[4 * ks + 3]); }
                    else { pw[ks >> 1].x = pk2(pp[4 * ks + 0], pp[4 * ks + 1]); pw[ks >> 1].y = pk2(pp[4 * ks + 2], pp[4 * ks + 3]); }
                    SB();
                }
                l_run += rs;
                float mx = fmaxf(fmaxf(sa[0], sa[1]), sa[2]);
#pragma unroll
                for (int r = 3; r < 16; ++r) mx = fmaxf(mx, sa[r]);
                mx = fmaxf(mx, other_half(mx, hh));
                const float mnew = fmaxf(m_raw, mx);
                const bool resc = __any(mnew > m_raw);
                const float fsc = fexp2(c1 * (m_raw - mnew));
                m_raw = mnew;
                const float nm = -c1 * m_raw;
                SB();
                LAS unsigned char* Vp = F.lds + pvoff;
                bf16x8 vq[3]; vq[0] = DA_VFR(Vp, 0, 0, 0); vq[1] = DA_VFR(Vp, 0, 0, 1);
                SB();
#pragma unroll
                for (int j = 0; j < 8; ++j) { const int st = j >> 2, dt = j & 3;
                    if (j + 2 < 8) vq[(j + 2) % 3] = DA_VFR(Vp, 0, (j + 2) >> 2, (j + 2) & 3);
                    o[dt] = MFMA32(vq[j % 3], __builtin_bit_cast(bf16x8, pw[st]), o[dt]);
                    pp[2 * j] = fexp2(fmaf(sa[2 * j], c1, nm)); pp[2 * j + 1] = fexp2(fmaf(sa[2 * j + 1], c1, nm));
                    SB(); }
                l_run *= fsc;
                if (resc) {
#pragma unroll
                    for (int dt = 0; dt < 4; ++dt)
#pragma unroll
                        for (int r = 0; r < 16; ++r) o[dt][r] *= fsc; }
                pending = true; pvoff = sbase + 16384 + sub * 32 * 256;
            }
        } else if (pending) { DA_RETIRE(); }
        DA_FLAG(kt);
    }
    if (pending) { DA_RETIRE(); }
#undef DA_RETIRE
    (void)alive;
#undef SB
#undef DA_FLAG
#undef DA_VFR
#undef DA_DMA
    AT_WAIT_BAR(0);
    const float ltot = l_run + other_half(l_run, hh); const float linv = 1.0f / ltot;
    LAS float* ex = (LAS float*)F.lds;
    if (map == 1) {
#pragma unroll
        for (int dt = 0; dt < 4; ++dt)
#pragma unroll
            for (int r = 0; r < 16; ++r) ex[((wq * 4 + dt) * 16 + r) * 64 + F.lane] = o[dt][r] * linv;
    }
    __syncthreads();
    if (map == 0) {
        gfp lp = GIN(I_LAM) + (size_t)l * 256;
        const float d1 = wave_sum(lp[F.lane] * lp[64 + F.lane]), d2 = wave_sum(lp[128 + F.lane] * lp[192 + F.lane]);
        const float lam = expf(d1) - expf(d2) + a->lam_init[l];
        float ss = 0.f;
#pragma unroll
        for (int dt = 0; dt < 4; ++dt)
#pragma unroll
            for (int r = 0; r < 16; ++r) { const float v = o[dt][r] * linv - lam * ex[((wq * 4 + dt) * 16 + r) * 64 + F.lane]; o[dt][r] = v; ss += v * v; }
        ss += other_half(ss, hh);
        const float sc = (1.0f / sqrtf(ss * (1.0f / 128.0f) + EPS)) * (1.0f - a->lam_init[l]);
        gfp sg = GIN(I_SUBLN) + (size_t)l * 128;
        bf16_t* yrow = YB + (rowbase + qpos) * 512 + h * 128;
#pragma unroll
        for (int dt = 0; dt < 4; ++dt)
#pragma unroll
            for (int G4 = 0; G4 < 4; ++G4) { const int d = 32 * dt + 8 * G4 + 4 * hh; const f32x4 gg = *(const GAS f32x4*)(sg + d);
                u32x2 w; w.x = pk2(o[dt][4 * G4] * sc * gg[0], o[dt][4 * G4 + 1] * sc * gg[1]); w.y = pk2(o[dt][4 * G4 + 2] * sc * gg[2], o[dt][4 * G4 + 3] * sc * gg[3]);
                *(u32x2*)(yrow + d) = w; }
    }
    __syncthreads();
}

__device__ __forceinline__ void mixer_phase(Frame& F, ArgsP a, int l, int qrep, int ulo, int uhi) {
    volatile LAS int* qs = (volatile LAS int*)(F.lds + MISC_OFF + 640);
    const int home = (int)(xb_xcc_id() & 7u);
    unsigned* qbase = (unsigned*)(F.ctl + CW_Q + ((l * 2 + qrep) * 8) * 64);
    for (;;) {
        if (F.tid == 0) { int got = -1;
            for (int sidx = 0; sidx < 8 && got < 0; ++sidx) { const int q = (home + sidx) & 7; unsigned* hd = qbase + q * 64;
                if (__hip_atomic_load(hd, __ATOMIC_RELAXED, __HIP_MEMORY_SCOPE_AGENT) < (unsigned)(uhi - ulo)) {
                    const unsigned j = __hip_atomic_fetch_add(hd, 1u, __ATOMIC_RELAXED, __HIP_MEMORY_SCOPE_AGENT);
                    if (j < (unsigned)(uhi - ulo)) got = q * 256 + (int)j + ulo; } }
            qs[0] = got; }
        __syncthreads();
        const int tk = qs[0];
        __syncthreads();
        if (tk < 0) break;
        const int q = tk >> 8, j = tk & 255;
        if (j < 64) { const int hsel = q & 1; const int h = (j & 1) ? (hsel ? 1 : 0) : (hsel ? 2 : 3); da_unit(F, a, l, q >> 1, h, 31 - (j >> 1)); }
        else if (j < 128) { const int jj = j - 64; sb_unit(F, (q >> 1) * 128 + (4 * (q & 1) + (jj & 3)) * 16 + (15 - (jj >> 2))); }
        else { const int jj = j - 128; gmlp_unit(F, a, l, (q * 16 + (jj >> 2)) * 4 + (jj & 3)); }
    }
}

constexpr int PH_PER_LAYER = 8, N_PHASES = DEPTH * PH_PER_LAYER + 1;
__global__ void __launch_bounds__(NTHREADS, 2) fwd_kernel(Args args) {
    extern __shared__ __attribute__((aligned(16))) unsigned char lds_raw[];
    Frame F;
    F.lds = (LAS unsigned char*)lds_raw;
    F.tid = threadIdx.x; F.lane = F.tid & 63; F.wave = __builtin_amdgcn_readfirstlane(F.tid >> 6);
    F.G = gridDim.x; { const int bx = blockIdx.x; F.vcu = (F.G % 8 == 0) ? (bx % 8) * (F.G / 8) + bx / 8 : bx; }
    F.ws = args.ws; F.ctl = (gu32*)(args.ws + WS_CTL);
    volatile LAS unsigned* MISC = (volatile LAS unsigned*)(F.lds + MISC_OFF);
    for (int u = F.tid; u < 256; u += NTHREADS) MISC[u] = 0u;
    __syncthreads();
#if MK_MULTI
#define GRID_BAR() do { } while (0)
#else
    XcdBarrier bar = xcd_barrier_post((unsigned*)(F.ctl + CW_BAR), MISC + 8);
#define GRID_BAR() xcd_barrier(bar)
#endif
    const int lo = args.ph_lo, hi = args.ph_hi;
#ifndef PHASE_MASK
#define PHASE_MASK 0x1ff
#endif
#define IN(k) (lo <= (k) && (k) < hi && ((PHASE_MASK >> ((k) % PH_PER_LAYER + ((k) == DEPTH * PH_PER_LAYER ? 8 : 0))) & 1))
#define SEAM(k) do { if (IN((k) + 1)) { GRID_BAR(); if (PROBE_DUP == 99) GRID_BAR(); } } while (0)
    const Frame F0 = F;
    ArgsP args_p;
    LAS int* const PFX = (LAS int*)(F.lds + MISC_OFF + 1024);
    LAS int* const CNT = (LAS int*)(F.lds + MISC_OFF + 1024 + 4 * 192);
    unsigned long long t0_ = 0, tacc_ = 0;
    for (int l = 0; l < DEPTH; ++l) {
        const int p0 = l * PH_PER_LAYER;
        F = phase_frame(F0);
        { ArgsP ap = (ArgsP)__builtin_amdgcn_kernarg_segment_ptr(); asm volatile("" : "+s"(ap)); args_p = ap; }
        int bx = blockIdx.x; asm volatile("" : "+s"(bx));
        bf16_t* const Wb = (bf16_t*)(F.ws + WS_W);
        bf16_t* const ACT = (bf16_t*)(F.ws + WS_ACT);
        bf16_t* const PROJ = (bf16_t*)(F.ws + WS_PROJ);
        bf16_t* const Y = (bf16_t*)(F.ws + WS_Y);
        if (PROBE_T == 0) t0_ = __builtin_amdgcn_s_memrealtime();
        if (IN(p0 + 0)) { REP(10) convert_weights(F, args_p, l); if (l == 0) norm_rows<0>(F, args_p, l); else { if (PROBE_DUP == 98) norm_rows<3>(F, args_p, l); norm_rows<1>(F, args_p, l); } SEAM(p0 + 0); if (PROBE_T == 0) tacc_ += __builtin_amdgcn_s_memrealtime() - t0_; }
        if (PROBE_T == 1) t0_ = __builtin_amdgcn_s_memrealtime();
        if (IN(p0 + 1)) { REP(1) { pg8::DenseOrder S; S.init(T, INW, DM, Wb + W_IN / 2, F.G, bx); pg8::EpiProj E{PROJ, (unsigned*)(F.ctl + CW_KMAX + 64 * l)};
            pg8::gemm_phase<pg8::EpiProj, pg8::DenseOrder, true>(F.lds, F.wave, ACT, DM, S, E); } SEAM(p0 + 1); if (PROBE_T == 1) tacc_ += __builtin_amdgcn_s_memrealtime() - t0_; }
        if (PROBE_T == 2) t0_ = __builtin_amdgcn_s_memrealtime();
        if (IN(p0 + 2)) { mixer_phase(F, args_p, l, 0, 0, 192);
            if (PROBE_DUP >= 20 && PROBE_DUP <= 22) { GRID_BAR(); const unsigned long long td_ = __builtin_amdgcn_s_memrealtime();
                mixer_phase(F, args_p, l, 1, (PROBE_DUP - 20) * 64, (PROBE_DUP - 19) * 64); GRID_BAR(); tacc_ += __builtin_amdgcn_s_memrealtime() - td_; }
            SEAM(p0 + 2); if (PROBE_T == 2) tacc_ += __builtin_amdgcn_s_memrealtime() - t0_; }
        if (PROBE_T == 3) t0_ = __builtin_amdgcn_s_memrealtime();
        if (IN(p0 + 3)) { REP(3) {
            pg8::UpOrder S; S.D.init(T, DM, 512, Wb + W_UP / 2, F.G, bx); S.Bt = Wb + W_UP / 2; pg8::EpiGate3 E{ACT, PROJ + C_G};
            pg8::gemm_phase<pg8::EpiGate3, pg8::UpOrder, true>(F.lds, F.wave, Y, 512, S, E); }
            SEAM(p0 + 3); if (PROBE_T == 3) tacc_ += __builtin_amdgcn_s_memrealtime() - t0_; }
        if (PROBE_T == 4) t0_ = __builtin_amdgcn_s_memrealtime();
        if (IN(p0 + 4)) {
            { pg8::DenseOrder S; S.init(T, DM, DM, Wb + W_OUT / 2, F.G, bx); pg8::EpiRes E{(float*)(F.ws + WS_X), (float*)(F.ws + WS_X)};
            pg8::gemm_phase<pg8::EpiRes, pg8::DenseOrder, false>(F.lds, F.wave, ACT, DM, S, E); } SEAM(p0 + 4); if (PROBE_T == 4) tacc_ += __builtin_amdgcn_s_memrealtime() - t0_; }
        if (PROBE_T == 5) t0_ = __builtin_amdgcn_s_memrealtime();
        if (IN(p0 + 5)) { if (PROBE_DUP == 96) t2_phase<true>(F, args_p, l); t2_phase<false>(F, args_p, l); SEAM(p0 + 5); if (PROBE_T == 5) tacc_ += __builtin_amdgcn_s_memrealtime() - t0_; }
        if (IN(p0 + 6) || IN(p0 + 7)) {
            if (F.tid == 0) { int run = 0;
                for (int e = 0; e < NE; ++e) { const int c = (int)__hip_atomic_load((unsigned*)(F.ctl + CW_CNT + 64 * l + e), __ATOMIC_RELAXED, __HIP_MEMORY_SCOPE_AGENT); CNT[e] = c; PFX[e] = run; run += (c + 255) >> 8; }
                PFX[16] = run; }
            __syncthreads();
            if (F.tid < 160) { int e = 0;
#pragma unroll
                for (int j = 1; j < 16; ++j) e += (PFX[j] <= F.tid) ? 1 : 0;
                PFX[32 + F.tid] = e; }
            __syncthreads();
        }
        if (PROBE_T == 6) t0_ = __builtin_amdgcn_s_memrealtime();
        if (IN(p0 + 6)) { REP(6) { MoeOrder<true> S{F.G, bx, 4, PFX, CNT, Wb + W_13 / 2, (size_t)DM * DM * 2, DM, (const unsigned*)(F.ws + WS_LIST)};
            pg8::EpiMoe1 E{(bf16_t*)(F.ws + WS_H), (const float*)(F.ws + WS_WL)};
            pg8::gemm_phase<pg8::EpiMoe1, MoeOrder<true>, true, true>(F.lds, F.wave, ACT, DM, S, E); } SEAM(p0 + 6); if (PROBE_T == 6) tacc_ += __builtin_amdgcn_s_memrealtime() - t0_; }
        if (PROBE_T == 7) t0_ = __builtin_amdgcn_s_memrealtime();
        if (IN(p0 + 7)) { REP(7) { MoeOrder<false> S{F.G, bx, 4, PFX, CNT, Wb + W_2 / 2, (size_t)DM * DFF * 2, DFF, (const unsigned*)(F.ws + WS_LIST)};
            pg8::EpiMoe2 E{(bf16_t*)(F.ws + WS_YS), (const unsigned*)(F.ws + WS_LIST)};
            pg8::gemm_phase<pg8::EpiMoe2, MoeOrder<false>, true>(F.lds, F.wave, (const bf16_t*)(F.ws + WS_H), DFF, S, E); } SEAM(p0 + 7); if (PROBE_T == 7) tacc_ += __builtin_amdgcn_s_memrealtime() - t0_; }
    }
    F = phase_frame(F0);
    { ArgsP ap = (ArgsP)__builtin_amdgcn_kernarg_segment_ptr(); asm volatile("" : "+s"(ap)); args_p = ap; }
    if (PROBE_T == 8) t0_ = __builtin_amdgcn_s_memrealtime();
    if (IN(DEPTH * PH_PER_LAYER)) norm_rows<2>(F, args_p, 0);
    if (PROBE_T == 8) tacc_ += __builtin_amdgcn_s_memrealtime() - t0_;
    if ((PROBE_T >= 0 || PROBE_DUP >= 20) && blockIdx.x == 0) { const unsigned long long te_ = __builtin_amdgcn_s_memrealtime(); while (__builtin_amdgcn_s_memrealtime() - te_ < tacc_) __builtin_amdgcn_s_sleep(8); }
#undef IN
#undef SEAM
}

extern "C" void kernel_launch(void* const* d_in, const int* in_sizes, int n_in, void* d_out, int out_size, void* d_ws, size_t ws_size, hipStream_t stream) {
    static int grid = 0;
    if (grid == 0) {
        if (n_in != 19 || in_sizes[0] != T * DM || out_size != T * DM || ws_size < WS_END) { fprintf(stderr, "kernel_launch: unexpected shapes / workspace (n_in %d, ws %zu); nothing launched\n", n_in, ws_size); grid = -1; return; }
        int dev = 0, cus = 0, per_cu = 0;
        if (hipGetDevice(&dev) != hipSuccess || hipDeviceGetAttribute(&cus, hipDeviceAttributeMultiprocessorCount, dev) != hipSuccess) { grid = -1; return; }
        if (hipFuncSetAttribute((const void*)fwd_kernel, hipFuncAttributeMaxDynamicSharedMemorySize, LDS_BYTES) != hipSuccess) { fprintf(stderr, "kernel_launch: hipFuncSetAttribute failed\n"); grid = -1; return; }
        if (hipOccupancyMaxActiveBlocksPerMultiprocessor(&per_cu, (const void*)fwd_kernel, NTHREADS, LDS_BYTES) != hipSuccess || per_cu < 1) fprintf(stderr, "kernel_launch: occupancy query reports %d\n", per_cu);
        (void)hipGetLastError();
        grid = cus;
        if (grid != 256) { fprintf(stderr, "kernel_launch: built for 256 CUs, found %d\n", cus); grid = -1; return; }
    }
    if (grid < 0) return;
    if (hipMemsetAsync((char*)d_ws + WS_CTL, 0, CTL_ZERO_BYTES, stream) != hipSuccess) return;
    Args a{};
    for (int i = 0; i < 19; ++i) a.in[i] = (const float*)d_in[i];
    a.out = (float*)d_out; a.ws = (unsigned char*)d_ws;
    for (int l = 0; l < DEPTH; ++l) a.lam_init[l] = (float)(0.8 - 0.6 * exp(-0.3 * (double)l));
#if MK_MULTI
    for (int p = 0; p < N_PHASES; ++p) { a.ph_lo = p; a.ph_hi = p + 1; hipLaunchKernelGGL(fwd_kernel, dim3(grid), dim3(NTHREADS), LDS_BYTES, stream, a); }
#else
    a.ph_lo = 0; a.ph_hi = N_PHASES;
    hipLaunchKernelGGL(fwd_kernel, dim3(grid), dim3(NTHREADS), LDS_BYTES, stream, a);
#endif
}
```
